# Optimizing an MI355X kernel written in HIP

```python
import math
import jax, jax.numpy as jnp
from jax import lax
import numpy as np

D_MODEL = 2048
BATCH = 4
SEQ = 8192
DEPTH = 1
DEC_BATCH = 32
DEC_SEQ = 32
PAST_LEN = 4096

CHUNK = 64
D_MIX = D_MODEL
D_ATT = D_MIX // 2
D_SSM = D_MIX - D_ATT
HEAD_DIM = 128
N_HEADS = D_ATT // HEAD_DIM
SSM_GROUP = 16
N_GROUPS = D_SSM // SSM_GROUP
STATE = 64
D_PLE = 256
Q_BLOCK = 128
EPS = 1e-6
NEG_INF = -1e30

OFF_K = D_ATT
OFF_V = 2 * D_ATT
OFF_F = 3 * D_ATT
OFF_GA = 3 * D_ATT + N_HEADS
OFF_U = 4 * D_ATT + N_HEADS
OFF_GS = OFF_U + D_SSM
D_IN = OFF_GS + D_SSM

kernel_name = 'fox_s5_hymba_stream_step'


def _rmsnorm(x, g):
    xf = x.astype(jnp.float32)
    y = xf * lax.rsqrt(jnp.mean(xf * xf, axis=-1, keepdims=True) + EPS)
    return (y * g.astype(jnp.float32)).astype(x.dtype)


def _fox_block(q, cq, qpos, k, v, ck_t, kpos):
    s = jnp.einsum('bthd,bshd->bhts', q, k, preferred_element_type=jnp.float32) * (HEAD_DIM ** -0.5)
    bias = jnp.transpose(cq.astype(jnp.float32), (0, 2, 1))[..., :, None] - ck_t[:, :, None, :]
    mask = kpos[None, :] <= qpos[:, None]
    s = jnp.where(mask, s + bias, NEG_INF)
    pr = jax.nn.softmax(s, axis=-1)
    return jnp.einsum('bhts,bshd->bthd', pr.astype(v.dtype), v)


def _fox_attention(q, cq, qpos, k, v, ck, kpos):
    b, t = q.shape[0], q.shape[1]
    ck_t = jnp.transpose(ck.astype(jnp.float32), (0, 2, 1))
    if t <= Q_BLOCK:
        return _fox_block(q, cq, qpos, k, v, ck_t, kpos)
    nb = t // Q_BLOCK
    qb = q.reshape(b, nb, Q_BLOCK, N_HEADS, HEAD_DIM).transpose(1, 0, 2, 3, 4)
    cqb = cq.reshape(b, nb, Q_BLOCK, N_HEADS).transpose(1, 0, 2, 3)
    pb = qpos.reshape(nb, Q_BLOCK)
    ob = lax.map(lambda a: _fox_block(a[0], a[1], a[2], k, v, ck_t, kpos), (qb, cqb, pb))
    return ob.transpose(1, 0, 2, 3, 4).reshape(b, t, N_HEADS, HEAD_DIM)


def _ssm_combine(left, right):
    a1, b1 = left
    a2, b2 = right
    return a1 * a2, a2 * b1 + b2


def _s5(u, h0_re, h0_im, a_re, a_im, log_dt, b_re, b_im, c_re, c_im, d_skip, w_glu):
    f32 = jnp.float32
    b, t, _ = u.shape
    ug = u.astype(f32).reshape(b, t, N_GROUPS, SSM_GROUP)
    lam = lax.complex(a_re.astype(f32), a_im.astype(f32))
    dt = jnp.exp(log_dt.astype(f32))[:, None]
    a_bar = jnp.exp(lam * dt)
    b_bar = ((a_bar - 1.0) / lam)[:, :, None] * lax.complex(b_re.astype(f32), b_im.astype(f32))
    bu = jnp.einsum('gpc,btgc->btgp', b_bar, ug.astype(jnp.complex64))
    if h0_re is not None:
        h0 = lax.complex(h0_re.astype(f32), h0_im.astype(f32))
        bu = bu.at[:, 0].add(a_bar * h0)
    a_seq = jnp.broadcast_to(a_bar, (1, t, N_GROUPS, STATE))
    _, hs = lax.associative_scan(_ssm_combine, (a_seq, bu), axis=1)
    c = lax.complex(c_re.astype(f32), c_im.astype(f32))
    y = jnp.real(jnp.einsum('gcp,btgp->btgc', c, hs)) + d_skip.astype(f32).reshape(N_GROUPS, SSM_GROUP) * ug
    y = jax.nn.gelu(y.reshape(b, t, D_SSM))
    y = y * jax.nn.sigmoid(y @ w_glu.astype(f32))
    h_last = hs[:, -1]
    return y.astype(u.dtype), jnp.real(h_last), jnp.imag(h_last)


def _layer(h, pe, past, g_in, w_in, b_f, a_re, a_im, log_dt, b_re, b_im, c_re, c_im,
           d_skip, w_glu, w_out, w_pe, g_pe, w_pg):
    bsz, t, _ = h.shape
    n = _rmsnorm(h, g_in)
    z = n @ w_in
    q, k, v, fl, ga, u, gs = jnp.split(z, [OFF_K, OFF_V, OFF_F, OFF_GA, OFF_U, OFF_GS], axis=-1)
    q = q.reshape(bsz, t, N_HEADS, HEAD_DIM)
    k = k.reshape(bsz, t, N_HEADS, HEAD_DIM)
    v = v.reshape(bsz, t, N_HEADS, HEAD_DIM)
    logf = jax.nn.log_sigmoid((fl + b_f).astype(jnp.float32))
    if past is None:
        k_all, v_all, logf_all, h0_re, h0_im = k, v, logf, None, None
        n_past = 0
    else:
        k_past, v_past, logf_past, h0_re, h0_im = past
        n_past = k_past.shape[1]
        k_all = jnp.concatenate([k_past.astype(k.dtype), k], axis=1)
        v_all = jnp.concatenate([v_past.astype(v.dtype), v], axis=1)
        logf_all = jnp.concatenate([logf_past.astype(jnp.float32), logf], axis=1)
    c_all = jnp.cumsum(logf_all, axis=1)
    kpos = jnp.arange(n_past + t)
    qpos = n_past + jnp.arange(t)
    att = _fox_attention(q, c_all[:, n_past:], qpos, k_all, v_all, c_all, kpos).reshape(bsz, t, D_ATT)
    ssm, s_re, s_im = _s5(u, h0_re, h0_im, a_re, a_im, log_dt, b_re, b_im, c_re, c_im, d_skip, w_glu)
    mixed = jnp.concatenate([att * jax.nn.silu(ga), ssm * jax.nn.silu(gs)], axis=-1)
    h = h + mixed @ w_out
    e = _rmsnorm(pe @ w_pe, g_pe)
    h = h + e * jax.nn.sigmoid(h @ w_pg)
    return h, k, v, logf, s_re, s_im


def _trunk(x, p, past, g_in, w_in, b_f, a_re, a_im, log_dt, b_re, b_im, c_re, c_im,
           d_skip, w_glu, w_out, w_pe, g_pe, w_pg, g_final):
    h = x
    ks, vs, lfs, srs, sis = [], [], [], [], []
    for i in range(DEPTH):
        lp = None if past is None else (past[0][i], past[1][i], past[2][i], past[3][i], past[4][i])
        h, k, v, lf, sr, si = _layer(h, p[i], lp, g_in[i], w_in[i], b_f[i], a_re[i], a_im[i], log_dt[i],
                                     b_re[i], b_im[i], c_re[i], c_im[i], d_skip[i], w_glu[i], w_out[i],
                                     w_pe[i], g_pe[i], w_pg[i])
        ks.append(k)
        vs.append(v)
        lfs.append(lf)
        srs.append(sr)
        sis.append(si)
    y = _rmsnorm(h, g_final)
    return y, jnp.stack(ks), jnp.stack(vs), jnp.stack(lfs), jnp.stack(srs), jnp.stack(sis)


def setup_inputs(seed: int = 0) -> dict:
    key = jax.random.key(seed)
    ks = jax.random.split(key, 32)
    nrm = jax.random.normal
    f32 = jnp.float32
    x_prompt = nrm(ks[0], (BATCH, SEQ, D_MODEL), f32)
    x_sample = nrm(ks[1], (DEC_BATCH, DEC_SEQ, D_MODEL), f32)
    p_prompt = nrm(ks[2], (DEPTH, BATCH, SEQ, D_PLE), f32)
    p_sample = nrm(ks[3], (DEPTH, DEC_BATCH, DEC_SEQ, D_PLE), f32)
    cache_k = nrm(ks[4], (DEPTH, DEC_BATCH, PAST_LEN, N_HEADS, HEAD_DIM), f32)
    cache_v = nrm(ks[5], (DEPTH, DEC_BATCH, PAST_LEN, N_HEADS, HEAD_DIM), f32)
    cache_logf = jax.nn.log_sigmoid(2.0 + nrm(ks[6], (DEPTH, DEC_BATCH, PAST_LEN, N_HEADS), f32))
    state_ssm_re = 0.1 * nrm(ks[7], (DEPTH, DEC_BATCH, N_GROUPS, STATE), f32)
    state_ssm_im = 0.1 * nrm(ks[8], (DEPTH, DEC_BATCH, N_GROUPS, STATE), f32)
    g_in = 1.0 + 0.02 * nrm(ks[9], (DEPTH, D_MODEL), f32)
    w_in = nrm(ks[10], (DEPTH, D_MODEL, D_IN), f32) * D_MODEL ** -0.5
    b_f = 2.0 + 0.1 * nrm(ks[11], (DEPTH, N_HEADS), f32)
    a_re = -0.5 + 0.01 * nrm(ks[12], (DEPTH, N_GROUPS, STATE), f32)
    a_im = math.pi * jnp.arange(STATE, dtype=f32) + 0.01 * nrm(ks[13], (DEPTH, N_GROUPS, STATE), f32)
    log_dt = jax.random.uniform(ks[14], (DEPTH, N_GROUPS), f32, math.log(1e-3), math.log(1e-1))
    b_re = nrm(ks[15], (DEPTH, N_GROUPS, STATE, SSM_GROUP), f32) * (2 * SSM_GROUP) ** -0.5
    b_im = nrm(ks[16], (DEPTH, N_GROUPS, STATE, SSM_GROUP), f32) * (2 * SSM_GROUP) ** -0.5
    c_re = nrm(ks[17], (DEPTH, N_GROUPS, SSM_GROUP, STATE), f32) * STATE ** -0.5
    c_im = nrm(ks[18], (DEPTH, N_GROUPS, SSM_GROUP, STATE), f32) * STATE ** -0.5
    d_skip = nrm(ks[19], (DEPTH, D_SSM), f32)
    w_glu = nrm(ks[20], (DEPTH, D_SSM, D_SSM), f32) * D_SSM ** -0.5
    w_out = nrm(ks[21], (DEPTH, D_MIX, D_MODEL), f32) * D_MIX ** -0.5
    w_pe = nrm(ks[22], (DEPTH, D_PLE, D_MODEL), f32) * D_PLE ** -0.5
    g_pe = 1.0 + 0.02 * nrm(ks[23], (DEPTH, D_MODEL), f32)
    w_pg = nrm(ks[24], (DEPTH, D_MODEL, D_MODEL), f32) * D_MODEL ** -0.5
    g_final = 1.0 + 0.02 * nrm(ks[25], (D_MODEL,), f32)
    return {'x_prompt': x_prompt, 'x_sample': x_sample, 'p_prompt': p_prompt, 'p_sample': p_sample,
            'cache_k': cache_k, 'cache_v': cache_v, 'cache_logf': cache_logf,
            'state_ssm_re': state_ssm_re, 'state_ssm_im': state_ssm_im,
            'g_in': g_in, 'w_in': w_in, 'b_f': b_f, 'a_re': a_re, 'a_im': a_im, 'log_dt': log_dt,
            'b_re': b_re, 'b_im': b_im, 'c_re': c_re, 'c_im': c_im, 'd_skip': d_skip, 'w_glu': w_glu,
            'w_out': w_out, 'w_pe': w_pe, 'g_pe': g_pe, 'w_pg': w_pg, 'g_final': g_final}


def reference(x_prompt, x_sample, p_prompt, p_sample, cache_k, cache_v, cache_logf,
              state_ssm_re, state_ssm_im, g_in, w_in, b_f, a_re, a_im, log_dt, b_re, b_im,
              c_re, c_im, d_skip, w_glu, w_out, w_pe, g_pe, w_pg, g_final):
    y_prompt, k_p, v_p, lf_p, sr_p, si_p = _trunk(
        x_prompt, p_prompt, None, g_in, w_in, b_f, a_re, a_im, log_dt, b_re, b_im, c_re, c_im,
        d_skip, w_glu, w_out, w_pe, g_pe, w_pg, g_final)
    y_sample, k_s, v_s, lf_s, sr_s, si_s = _trunk(
        x_sample, p_sample, (cache_k, cache_v, cache_logf, state_ssm_re, state_ssm_im),
        g_in, w_in, b_f, a_re, a_im, log_dt, b_re, b_im, c_re, c_im,
        d_skip, w_glu, w_out, w_pe, g_pe, w_pg, g_final)
    return (y_prompt, y_sample, k_p, v_p, lf_p, sr_p, si_p, k_s, v_s, lf_s, sr_s, si_s)
```

```cpp
#include <hip/hip_runtime.h>
#include <cstdio>
#include <cstdint>

#ifndef MK_ONE_LAUNCH
#define MK_ONE_LAUNCH 1
#endif
#ifndef DBG_GP
#define DBG_GP 0
#endif

namespace pg8 {
#define PG8_LAS __attribute__((address_space(3)))
typedef unsigned short bf16_t;
typedef short bf16x8 __attribute__((ext_vector_type(8)));
typedef float f32x4 __attribute__((ext_vector_type(4)));
typedef unsigned u32x4 __attribute__((ext_vector_type(4)));
constexpr int BM = 256, BK = 64, HALF = 128, HTB = HALF * BK * 2  , STAGE_BYTES = 8 * HTB, NXCD = 8, WGM = 8;

__host__ __device__ __forceinline__ int lds_byte(int r, int c) { const int st = (r >> 4) * 2 + (c >> 5), rr = r & 15, cc = c & 31, ob = rr * 64 + cc * 2; return st * 1024 + (ob ^ (((ob >> 9) & 1) << 5)); }
__host__ __device__ __forceinline__ void stage_rc(int b, int& R, int& C) { const int st = b / 1024, sb = b % 1024, swz = sb ^ (((sb >> 9) & 1) << 5); R = (st >> 1) * 16 + swz / 64; C = (st & 1) * 32 + (swz % 64) / 2; }
__host__ __device__ __forceinline__ int perm32(int rho) { const int n = rho >> 4, i = rho & 15; return 8 * (i >> 2) + 4 * n + (i & 3); }

struct Unit { int pm, pn, g; };
struct Gemm { int lda, ldb, K; };

struct StaticOrder {
    const bf16_t* A; const bf16_t* Bt; size_t ta, tb;
    int nM, nN, nwg, G, c;
    __device__ void init(const bf16_t* A_, const bf16_t* Bt_, int lda, int ldb, int M, int N, int G_, int c_) { A = A_; Bt = Bt_; ta = (size_t)BM * lda * 2; tb = (size_t)BM * ldb * 2; nM = M / BM; nN = N / BM; nwg = nM * nN; G = G_; c = c_; }
    __device__ bool next(int i, Unit& u) const {
        const long L = (long)i * G + c; if (L >= nwg) return false;
        int wgid = (int)L; { const int q = nwg / NXCD, r = nwg % NXCD, xcd = wgid % NXCD, off = wgid / NXCD; wgid = (xcd < r ? xcd * (q + 1) : r * (q + 1) + (xcd - r) * q) + off; }
        const int nig = WGM * nN, gid = wgid / nig, fm = gid * WGM, gsz = (nM - fm) < WGM ? (nM - fm) : WGM;
        u.pm = fm + ((wgid % nig) % gsz); u.pn = (wgid % nig) / gsz; u.g = 0; return true;
    }
    __device__ __forceinline__ const char* a_ptr(const Unit& u) const { return (const char*)A + (size_t)u.pm * ta; }
    __device__ __forceinline__ const char* b_ptr(const Unit& u) const { return (const char*)Bt + (size_t)u.pn * tb; }
    __device__ __forceinline__ void a_ready(const Unit&) const {}
    __device__ __forceinline__ void done(const Unit&) const {}
};

__device__ __forceinline__ unsigned cvt_pk_bf16(float lo, float hi) { unsigned r; asm volatile("v_cvt_pk_bf16_f32 %0, %1, %2" : "=v"(r) : "v"(lo), "v"(hi)); return r; }
__device__ __forceinline__ float bf_lo(unsigned w) { return __uint_as_float(w << 16); }
__device__ __forceinline__ float bf_hi(unsigned w) { return __uint_as_float(w & 0xffff0000u); }
__device__ __forceinline__ float sigmoidf_(float x) { return __builtin_amdgcn_rcpf(1.0f + __builtin_amdgcn_exp2f(-1.4426950408889634f * x)); }
__device__ __forceinline__ float siluf_(float x) { return x * sigmoidf_(x); }
__device__ __forceinline__ float gelu_tanh_(float x) { const float t = 0.7978845608028654f * (x + 0.044715f * x * x * x); return x * sigmoidf_(2.0f * t); }
__device__ __forceinline__ u32x4 pack8f(const f32x4& a, const f32x4& b) { u32x4 w; w.x = cvt_pk_bf16(a[0], a[1]); w.y = cvt_pk_bf16(a[2], a[3]); w.z = cvt_pk_bf16(b[0], b[1]); w.w = cvt_pk_bf16(b[2], b[3]); return w; }

template <class Epi, class Sched, bool ALIGN_EPI = false, bool SP2 = false>
__device__ __forceinline__ void gemm_phase(PG8_LAS unsigned char* lds, const Gemm g, const Sched& S, const Epi& E) {
    const int tid = threadIdx.x, wid = __builtin_amdgcn_readfirstlane(tid >> 6), lane = tid & 63, wr = wid >> 2, wc = wid & 3, fr = lane & 15, fq = lane >> 4;
    const int K = g.K, nt = K / BK;
    unsigned voffA[2], voffB[2];
#pragma unroll
    for (int i = 0; i < 2; ++i) { int R, C; stage_rc(tid * 16 + i * 8192, R, C); const int Rb = Epi::PERM ? ((R & ~31) + perm32(R & 31)) : R;
        voffA[i] = (unsigned)(R * g.lda + C) * 2u; voffB[i] = (unsigned)(Rb * g.ldb + C) * 2u; }
    const size_t kstep = (size_t)(BK * 2);
    const size_t hstepA = (size_t)HALF * g.lda * 2, hstepB = (size_t)HALF * g.ldb * 2;
    const unsigned ldsw = (unsigned)wid * 1024u;
    const int aoff = lds_byte(wr * 64 + fr, fq * 8), boff = lds_byte(wc * 32 + fr, fq * 8);
#define PG8_SA(b, h) (((b) * 2 + (h)) * HTB)
#define PG8_SB(b, h) ((4 + (b) * 2 + (h)) * HTB)
#define PG8_STAGE(bufoff, gbase, voff) do { _Pragma("unroll") for (int _i = 0; _i < 2; ++_i) \
        __builtin_amdgcn_global_load_lds((const unsigned*)((const char*)(gbase) + (voff)[_i]), (PG8_LAS unsigned*)(lds + (bufoff) + ldsw + _i * 8192), 16, 0, 0); } while (0)
#define PG8_LDA(dst, b, h) do { _Pragma("unroll") for (int m = 0; m < 4; ++m) _Pragma("unroll") for (int k = 0; k < 2; ++k) dst[m][k] = *(const PG8_LAS bf16x8*)(lds + PG8_SA(b, h) + aoff + m * 2048 + k * 1024); } while (0)
#define PG8_LDB(dst, b, h) do { _Pragma("unroll") for (int n = 0; n < 2; ++n) _Pragma("unroll") for (int k = 0; k < 2; ++k) dst[n][k] = *(const PG8_LAS bf16x8*)(lds + PG8_SB(b, h) + boff + n * 2048 + k * 1024); } while (0)
#define PG8_MMA(ai, bj, At, Bt) do { __builtin_amdgcn_s_setprio(1); _Pragma("unroll") for (int m = 0; m < 4; ++m) _Pragma("unroll") for (int n = 0; n < 2; ++n) _Pragma("unroll") for (int k = 0; k < 2; ++k) \
        acc[ai][bj][m][n] = __builtin_amdgcn_mfma_f32_16x16x32_bf16(Bt[n][k], At[m][k], acc[ai][bj][m][n], 0, 0, 0); __builtin_amdgcn_s_setprio(0); } while (0)
#define PG8_WAIT_V(n) asm volatile("s_waitcnt vmcnt(" #n ")" ::: "memory")
#define PG8_WAIT_L(n) asm volatile("s_waitcnt lgkmcnt(" #n ")" ::: "memory")
#define PG8_BAR __builtin_amdgcn_s_barrier()
#define PG8_SCHED __builtin_amdgcn_sched_barrier(0)
    Unit cur, nxt; int ui = 0;
    if (!S.next(0, cur)) return;
    f32x4 acc[2][2][4][2];
#pragma unroll
    for (int a = 0; a < 2; ++a)
#pragma unroll
        for (int b = 0; b < 2; ++b)
#pragma unroll
            for (int m = 0; m < 4; ++m)
#pragma unroll
                for (int n = 0; n < 2; ++n) acc[a][b][m][n] = (f32x4){0.f, 0.f, 0.f, 0.f};
    bf16x8 At[4][2], B0[2][2], B1[2][2];
    const char* cA = S.a_ptr(cur); const char* cB = S.b_ptr(cur);
    S.a_ready(cur);
    if constexpr (SP2) {
        PG8_STAGE(PG8_SB(0, 0), cB, voffB); PG8_STAGE(PG8_SB(0, 1), cB + hstepB, voffB); PG8_STAGE(PG8_SA(0, 0), cA, voffA); PG8_STAGE(PG8_SA(0, 1), cA + hstepA, voffA);
        if (wr == 1) PG8_BAR;
        PG8_WAIT_V(2); PG8_BAR;
        PG8_STAGE(PG8_SB(1, 0), cB + kstep, voffB); PG8_STAGE(PG8_SA(1, 0), cA + kstep, voffA); PG8_STAGE(PG8_SB(1, 1), cB + hstepB + kstep, voffB);
        PG8_WAIT_V(6); PG8_BAR;
    } else {
        PG8_STAGE(PG8_SB(0, 0), cB, voffB); PG8_STAGE(PG8_SA(0, 0), cA, voffA); PG8_STAGE(PG8_SB(0, 1), cB + hstepB, voffB); PG8_STAGE(PG8_SA(0, 1), cA + hstepA, voffA);
        if (wr == 1) PG8_BAR;
        PG8_WAIT_V(4); PG8_BAR;
        PG8_STAGE(PG8_SB(1, 0), cB + kstep, voffB); PG8_STAGE(PG8_SA(1, 0), cA + kstep, voffA); PG8_STAGE(PG8_SB(1, 1), cB + hstepB + kstep, voffB);
        PG8_WAIT_V(6); PG8_BAR;
    }
    for (;;) {
        const bool has_next = S.next(ui + 1, nxt);
        const char* nA = has_next ? S.a_ptr(nxt) : cA; const char* nB = has_next ? S.b_ptr(nxt) : cB;
        for (int t = 0; t < nt; t += 2) {
            const bool last = (t == nt - 2);
            const char* a1 = cA + (size_t)(t + 1) * kstep;
            const char* a2 = last ? nA : cA + (size_t)(t + 2) * kstep; const char* b2 = last ? nB : cB + (size_t)(t + 2) * kstep;
            const char* a3 = a2 + kstep; const char* b3 = b2 + kstep;
            if (last && has_next) S.a_ready(nxt);
            if constexpr (SP2) {
            PG8_LDB(B0, 0, 0); PG8_LDB(B1, 0, 1); PG8_SCHED; PG8_LDA(At, 0, 0); PG8_STAGE(PG8_SA(1, 1), a1 + hstepA, voffA);
            PG8_WAIT_V(8); PG8_WAIT_L(0); PG8_BAR; PG8_MMA(0, 0, At, B0); PG8_MMA(0, 1, At, B1); PG8_BAR; PG8_SCHED;
            PG8_LDA(At, 0, 1); PG8_STAGE(PG8_SB(0, 0), b2, voffB); PG8_STAGE(PG8_SB(0, 1), b2 + hstepB, voffB); PG8_STAGE(PG8_SA(0, 0), a2, voffA);
            PG8_WAIT_V(8); PG8_WAIT_L(0); PG8_BAR; PG8_MMA(1, 0, At, B0); PG8_MMA(1, 1, At, B1); PG8_BAR; PG8_SCHED;
            PG8_LDB(B0, 1, 0); PG8_LDB(B1, 1, 1); PG8_SCHED; PG8_LDA(At, 1, 0); PG8_STAGE(PG8_SA(0, 1), a2 + hstepA, voffA);
            PG8_WAIT_V(8); PG8_WAIT_L(0); PG8_BAR; PG8_MMA(0, 0, At, B0); PG8_MMA(0, 1, At, B1); PG8_BAR; PG8_SCHED;
            PG8_LDA(At, 1, 1); PG8_STAGE(PG8_SB(1, 0), b3, voffB); PG8_STAGE(PG8_SB(1, 1), b3 + hstepB, voffB); PG8_STAGE(PG8_SA(1, 0), a3, voffA);
            PG8_WAIT_V(8); PG8_WAIT_L(0); PG8_BAR; PG8_MMA(1, 0, At, B0); PG8_MMA(1, 1, At, B1); PG8_BAR; PG8_SCHED;
            } else {
            PG8_LDB(B0, 0, 0); PG8_SCHED; PG8_LDA(At, 0, 0); PG8_STAGE(PG8_SA(1, 1), a1 + hstepA, voffA);
            PG8_WAIT_L(8); PG8_BAR; PG8_WAIT_L(0); PG8_MMA(0, 0, At, B0); PG8_BAR; PG8_SCHED;
            PG8_LDB(B1, 0, 1); PG8_STAGE(PG8_SB(0, 0), b2, voffB);
            PG8_BAR; PG8_WAIT_L(0); PG8_MMA(0, 1, At, B1); PG8_BAR;
            PG8_LDA(At, 0, 1); PG8_STAGE(PG8_SA(0, 0), a2, voffA);
            PG8_BAR; PG8_WAIT_L(0); PG8_MMA(1, 0, At, B0); PG8_BAR; PG8_SCHED;
            PG8_STAGE(PG8_SB(0, 1), b2 + hstepB, voffB);
            PG8_WAIT_V(6); PG8_BAR; PG8_MMA(1, 1, At, B1); PG8_BAR;
            PG8_LDB(B0, 1, 0); PG8_SCHED; PG8_LDA(At, 1, 0); PG8_STAGE(PG8_SA(0, 1), a2 + hstepA, voffA);
            PG8_WAIT_L(8); PG8_BAR; PG8_WAIT_L(0); PG8_MMA(0, 0, At, B0); PG8_BAR; PG8_SCHED;
            PG8_LDB(B1, 1, 1); PG8_STAGE(PG8_SB(1, 0), b3, voffB);
            PG8_BAR; PG8_WAIT_L(0); PG8_MMA(0, 1, At, B1); PG8_BAR;
            PG8_LDA(At, 1, 1); PG8_STAGE(PG8_SA(1, 0), a3, voffA);
            PG8_BAR; PG8_WAIT_L(0); PG8_MMA(1, 0, At, B0); PG8_BAR; PG8_SCHED;
            PG8_STAGE(PG8_SB(1, 1), b3 + hstepB, voffB);
            PG8_WAIT_V(6); PG8_BAR; PG8_MMA(1, 1, At, B1); PG8_BAR;
            }
        }
        if constexpr (ALIGN_EPI) { if (wr == 0) PG8_BAR; }
        if constexpr (!Epi::AFTER_DRAIN) { E(acc, cur, wr, wc, fr, fq); S.done(cur); }
        if (!has_next) break;
#pragma unroll
        for (int a = 0; a < 2; ++a)
#pragma unroll
            for (int b = 0; b < 2; ++b)
#pragma unroll
                for (int m = 0; m < 4; ++m)
#pragma unroll
                    for (int n = 0; n < 2; ++n) acc[a][b][m][n] = (f32x4){0.f, 0.f, 0.f, 0.f};
        cur = nxt; cA = nA; cB = nB; ++ui;
        if constexpr (ALIGN_EPI) { if (wr == 1) PG8_BAR; }
    }
    PG8_WAIT_V(0);
    if constexpr (!ALIGN_EPI) { if (wr == 0) PG8_BAR; }
    PG8_BAR;
    if constexpr (Epi::AFTER_DRAIN) { E.fused(acc, cur, wr, wc, fr, fq, lds, wid, lane); S.done(cur); }
#undef PG8_SA
#undef PG8_SB
#undef PG8_STAGE
#undef PG8_LDA
#undef PG8_LDB
#undef PG8_MMA
#undef PG8_WAIT_V
#undef PG8_WAIT_L
#undef PG8_BAR
#undef PG8_SCHED
}
}

namespace att {
typedef unsigned short bf16;
typedef short bf16x8 __attribute__((ext_vector_type(8)));
typedef short s16x4 __attribute__((ext_vector_type(4)));
typedef float f32x16 __attribute__((ext_vector_type(16)));
typedef float f32x4 __attribute__((ext_vector_type(4)));
typedef unsigned u32x4 __attribute__((ext_vector_type(4)));
constexpr int D = 128, NW = 8, QBLK = 32, KVBLK = 64, QB = NW * QBLK;
constexpr int QP = 1024, KP = 1024, OP = 2048, GPI = 1024;
constexpr int SHM_V = KVBLK * D * 2, SHM_K = KVBLK * D * 2;
constexpr int LDS_BYTES = 2 * SHM_V + 2 * SHM_K + NW * 64 * 4;
constexpr float SCALE = 0.08838834764831845f, THR = 8.f;
template <class A, class Bt> struct same_t { static constexpr bool v = false; };
template <class A> struct same_t<A, A> { static constexpr bool v = true; };

#define KSWZ(row, colB) ((row) * 256 + ((colB) ^ (((row) & 7) << 4)))
#define SBAR() __builtin_amdgcn_sched_barrier(0)
__device__ __forceinline__ int v_st(int k, int c) { const int kk = (k & ~0xC) | ((k & 4) << 1) | ((k & 8) >> 1); return ((kk >> 3) * 4 + (c >> 5)) * 512 + ((kk & 7) * 32 + (c & 31)) * 2; }
__device__ __forceinline__ int v_rd_base(int lane) { return ((lane & 3) << 3) | (((lane >> 2) & 3) << 6) | (((lane >> 4) & 1) << 5) | (((lane >> 5) & 1) << 8); }
constexpr int v_rd_off(int d0, int ks, int half) { return d0 * 512 + ks * 4096 + half * 2048; }
__device__ __forceinline__ int crow(int r, int hi) { return (r & 3) + 8 * (r >> 2) + 4 * hi; }
__device__ __forceinline__ unsigned cvtpk(float lo, float hi) { unsigned r; asm volatile("v_cvt_pk_bf16_f32 %0, %1, %2" : "=v"(r) : "v"(lo), "v"(hi)); return r; }
__device__ __forceinline__ bf16x8 pack8(f32x4 a, f32x4 b) { u32x4 w = {cvtpk(a[0], a[1]), cvtpk(a[2], a[3]), cvtpk(b[0], b[1]), cvtpk(b[2], b[3])}; return *reinterpret_cast<bf16x8*>(&w); }
__device__ __forceinline__ bf16x8 ld8h(const bf16* p) { return *reinterpret_cast<const bf16x8*>(p); }

__device__ __forceinline__ void mask_tile(f32x16& p0, f32x16& p1, int dq) {
    const float NEG = -__builtin_inff();
#pragma unroll
    for (int r = 0; r < 16; ++r) {
        const int c = (r & 3) + 8 * (r >> 2);
        if (dq - c < 0) p0[r] = NEG;
        if (dq - c - 32 < 0) p1[r] = NEG;
    }
}
__device__ __forceinline__ void partialSM(f32x16& p0, f32x16& p1, float& m_reg, float& mn, float& alpha) {
    float pmax = p0[0]; for (int r = 1; r < 16; ++r) pmax = fmaxf(pmax, p0[r]); for (int r = 0; r < 16; ++r) pmax = fmaxf(pmax, p1[r]);
    { auto rr = __builtin_amdgcn_permlane32_swap(__float_as_uint(pmax), __float_as_uint(pmax), false, false);
      pmax = fmaxf(__uint_as_float(rr[0]), __uint_as_float(rr[1])); }
    constexpr float C2 = 1.4426950408889634f * SCALE;
    if (__builtin_expect(__all((pmax - m_reg) * SCALE <= THR), 1)) { mn = m_reg; alpha = 1.f; }
    else { mn = fmaxf(m_reg, pmax); alpha = __builtin_amdgcn_exp2f((m_reg - mn) * C2); m_reg = mn; }
    const float mnL = -mn * C2;
    for (int r = 0; r < 16; ++r) p0[r] = fmaf(p0[r], C2, mnL); for (int r = 0; r < 16; ++r) p1[r] = fmaf(p1[r], C2, mnL);
    for (int r = 0; r < 16; ++r) p0[r] = __builtin_amdgcn_exp2f(p0[r]);
}
__device__ __forceinline__ void finishSM(f32x16& p0, f32x16& p1, float alpha, float& l_reg, bf16x8& pa0, bf16x8& pa1, bf16x8& pa2, bf16x8& pa3) {
    for (int r = 0; r < 16; ++r) p1[r] = __builtin_amdgcn_exp2f(p1[r]);
    float ps = 0; for (int r = 0; r < 16; ++r) ps += p0[r]; for (int r = 0; r < 16; ++r) ps += p1[r];
    { auto rr = __builtin_amdgcn_permlane32_swap(__float_as_uint(ps), __float_as_uint(ps), false, false);
      ps = __uint_as_float(rr[0]) + __uint_as_float(rr[1]); }
    l_reg = l_reg * alpha + ps;
#define PK4(P, B_, OUT) do { unsigned a0 = cvtpk(P[B_+0], P[B_+1]), a1 = cvtpk(P[B_+2], P[B_+3]);                          \
        unsigned b0 = cvtpk(P[B_+4], P[B_+5]), b1 = cvtpk(P[B_+6], P[B_+7]);                                             \
        auto r0 = __builtin_amdgcn_permlane32_swap(a0, b0, false, false); auto r1 = __builtin_amdgcn_permlane32_swap(a1, b1, false, false); \
        u32x4 w = {r0[0], r1[0], r0[1], r1[1]}; OUT = *reinterpret_cast<bf16x8*>(&w); } while (0)
    PK4(p0, 0, pa0); PK4(p0, 8, pa1); PK4(p1, 0, pa2); PK4(p1, 8, pa3);
#undef PK4
}
__device__ __forceinline__ void loadck(f32x16& p0, f32x16& p1, const float* CK, int off  ) { const float* ckt = CK + off;
#pragma unroll
    for (int g = 0; g < 4; ++g) { const f32x4 a = *(const f32x4*)(ckt + 8 * g), b = *(const f32x4*)(ckt + 32 + 8 * g);
        p0[4 * g] = a[0]; p0[4 * g + 1] = a[1]; p0[4 * g + 2] = a[2]; p0[4 * g + 3] = a[3];
        p1[4 * g] = b[0]; p1[4 * g + 1] = b[1]; p1[4 * g + 2] = b[2]; p1[4 * g + 3] = b[3]; }
}
template <int KB, bool SK>
__device__ __forceinline__ void qkt(f32x16& p0, f32x16& p1, const char* K_lds, int r32, int hi, const bf16x8* qr, float cqv, bool act) {
    if (SK && !act) { const float NEG = -__builtin_inff();
#pragma unroll
        for (int r = 0; r < 16; ++r) { p0[r] = NEG; p1[r] = NEG; } return; }
#pragma unroll
    for (int r = 0; r < 16; ++r) { p0[r] = cqv - p0[r]; p1[r] = cqv - p1[r]; }
    const char* kb[4];
#pragma unroll
    for (int dd = 0; dd < 4; ++dd) kb[dd] = K_lds + KB * SHM_K + KSWZ(r32, (dd * 16 + hi * 8) * 2);
#pragma unroll
    for (int d0 = 0; d0 < 8; ++d0) { const char* a = kb[d0 & 3] + (d0 >> 2) * 128;
        bf16x8 b0 = *reinterpret_cast<const bf16x8*>(a);
        bf16x8 b1 = *reinterpret_cast<const bf16x8*>(a + 32 * 256);
        p0 = __builtin_amdgcn_mfma_f32_32x32x16_bf16(b0, qr[d0], p0, 0, 0, 0);
        p1 = __builtin_amdgcn_mfma_f32_32x32x16_bf16(b1, qr[d0], p1, 0, 0, 0); }
}
template <int VB, int ND>
__device__ __forceinline__ void pv_tile(f32x16* o, int vb0, bf16x8 pa0, bf16x8 pa1, bf16x8 pa2, bf16x8 pa3) {
#define TRRD(dst, off) asm volatile("ds_read_b64_tr_b16 %0, %1 offset:%2" : "=&v"(dst) : "v"(vb0), "i"(off) : "memory")
#define PV_D0(d0) do { s16x4 l0, l1, l2, l3, h0, h1, h2, h3; constexpr int b_ = VB * SHM_V + v_rd_off(d0, 0, 0); \
        TRRD(l0, b_); TRRD(h0, b_ + 2048); TRRD(l1, b_ + 4096); TRRD(h1, b_ + 6144); TRRD(l2, b_ + 8192); TRRD(h2, b_ + 10240); TRRD(l3, b_ + 12288); TRRD(h3, b_ + 14336); \
        asm volatile("s_waitcnt lgkmcnt(0)" ::: "memory"); SBAR();   \
        o[d0] = __builtin_amdgcn_mfma_f32_32x32x16_bf16((bf16x8){l0[0], l0[1], l0[2], l0[3], h0[0], h0[1], h0[2], h0[3]}, pa0, o[d0], 0, 0, 0);   \
        o[d0] = __builtin_amdgcn_mfma_f32_32x32x16_bf16((bf16x8){l1[0], l1[1], l1[2], l1[3], h1[0], h1[1], h1[2], h1[3]}, pa1, o[d0], 0, 0, 0);   \
        o[d0] = __builtin_amdgcn_mfma_f32_32x32x16_bf16((bf16x8){l2[0], l2[1], l2[2], l2[3], h2[0], h2[1], h2[2], h2[3]}, pa2, o[d0], 0, 0, 0);   \
        o[d0] = __builtin_amdgcn_mfma_f32_32x32x16_bf16((bf16x8){l3[0], l3[1], l3[2], l3[3], h3[0], h3[1], h3[2], h3[3]}, pa3, o[d0], 0, 0, 0); } while (0)
    PV_D0(0); if constexpr (ND == 4) { PV_D0(1); PV_D0(2); PV_D0(3); }
#undef PV_D0
#undef TRRD
}

template <class TKV> struct BlockRef { const bf16* Q; const TKV* K; const TKV* V; const TKV* Kn; const TKV* Vn; bf16* O; const bf16* G; const float* CQ; const float* CK; int np, P0, jlo, jhi; };
struct Seam { bf16x8 qr[8]; bf16x8 st_v0, st_v1, st_k0, st_k1; f32x4 sf0, sf1, sf2, sf3; };

#define TBASE(ref, base, basen, k0, half) ((F32 && (k0) >= (ref).np) ? (const char*)(basen) : (const char*)((base) + (size_t)((k0) + 32 * (half)) * KP))
#define VMW() asm volatile("s_waitcnt vmcnt(0)" ::: "memory")
#define VMWN(n) asm volatile("s_waitcnt vmcnt(%0)" :: "i"(n) : "memory")
#define SLOAD_H(ref, k0) do { S.st_v0 = *(const bf16x8*)(TBASE(ref, (ref).V, (ref).Vn, k0, 0) + rofs); S.st_v1 = *(const bf16x8*)(TBASE(ref, (ref).V, (ref).Vn, k0, 1) + rofs);              \
                              S.st_k0 = *(const bf16x8*)(TBASE(ref, (ref).K, (ref).Kn, k0, 0) + rofs); S.st_k1 = *(const bf16x8*)(TBASE(ref, (ref).K, (ref).Kn, k0, 1) + rofs); } while (0)
#define SWRITE_HK(bf) do { *(bf16x8*)(K_lds + (bf) * SHM_K + kws) = S.st_k0; *(bf16x8*)(K_lds + (bf) * SHM_K + kws + 32 * 256) = S.st_k1; } while (0)
#define SWRITE_HV(bf) do { *(bf16x8*)(V_lds + (bf) * SHM_V + vst0) = S.st_v0; *(bf16x8*)(V_lds + (bf) * SHM_V + vst0 + 8192) = S.st_v1; } while (0)
#define SWRITE_H(bf) do { SWRITE_HV(bf); SWRITE_HK(bf); } while (0)
#define SLOAD_FK(ref, k0) do { const char* r0_ = TBASE(ref, (ref).K, (ref).Kn, k0, 0) + rofs; const char* r1_ = TBASE(ref, (ref).K, (ref).Kn, k0, 1) + rofs; \
                               S.sf0 = *(const f32x4*)r0_; S.sf1 = *(const f32x4*)(r0_ + 16); S.sf2 = *(const f32x4*)r1_; S.sf3 = *(const f32x4*)(r1_ + 16); } while (0)
#define SLOAD_FV(ref, k0) do { const char* r0_ = TBASE(ref, (ref).V, (ref).Vn, k0, 0) + rofs; const char* r1_ = TBASE(ref, (ref).V, (ref).Vn, k0, 1) + rofs; \
                               S.sf0 = *(const f32x4*)r0_; S.sf1 = *(const f32x4*)(r0_ + 16); S.sf2 = *(const f32x4*)r1_; S.sf3 = *(const f32x4*)(r1_ + 16); } while (0)
#define SWRITE_KF(bf) do { *(bf16x8*)(K_lds + (bf) * SHM_K + kws) = pack8(S.sf0, S.sf1); *(bf16x8*)(K_lds + (bf) * SHM_K + kws + 32 * 256) = pack8(S.sf2, S.sf3); } while (0)
#define SWRITE_VF(bf) do { *(bf16x8*)(V_lds + (bf) * SHM_V + vst0) = pack8(S.sf0, S.sf1); *(bf16x8*)(V_lds + (bf) * SHM_V + vst0 + 8192) = pack8(S.sf2, S.sf3); } while (0)

template <class TKV, bool SOLO>
__device__ __forceinline__ void fox_prime(const BlockRef<TKV>& cur, char* lds, Seam& S) {
    constexpr bool F32 = same_t<TKV, float>::v;
    const int tid = threadIdx.x, wid = __builtin_amdgcn_readfirstlane(tid >> 6), lane = tid & 63, r32 = lane & 31, hi = lane >> 5;
    const int wq = SOLO ? 0 : wid;
    const int sr = tid >> 4, sc = (tid & 15) * 8, kws = KSWZ(sr, sc * 2); char* K_lds = lds + 2 * SHM_V;
    const unsigned rofs = (unsigned)(sr * KP + sc) * (unsigned)sizeof(TKV);
    const int kb0 = cur.jlo * KVBLK;
#pragma unroll
    for (int d0 = 0; d0 < 8; ++d0) S.qr[d0] = ld8h(cur.Q + (size_t)(wq * QBLK + r32) * QP + d0 * 16 + hi * 8);
    if constexpr (F32) { SLOAD_FK(cur, kb0); VMW(); SWRITE_KF(0); SBAR(); SLOAD_FV(cur, kb0); }
    else { SLOAD_H(cur, kb0); VMW(); SWRITE_HK(0); }
    __syncthreads();
}
template <class TKV, bool SOLO>
__device__ __forceinline__ void fox_block(const BlockRef<TKV>& cur, const BlockRef<TKV>& nxt, char* lds, Seam& S) {
    constexpr bool F32 = same_t<TKV, float>::v;
    constexpr bool SK = false;
    const int tid = threadIdx.x, wid = __builtin_amdgcn_readfirstlane(tid >> 6), lane = tid & 63, r32 = lane & 31, hi = lane >> 5;
    const int wq = SOLO ? 0 : wid;
    constexpr bool wact = true;
    const int j_lo = cur.jlo, NT = cur.jhi - cur.jlo;
    const int kbn = nxt.jlo * KVBLK;
    const int qlo = cur.P0 + wq * QBLK, qm = qlo + r32 - 4 * hi;
    char* V_lds = lds; char* K_lds = lds + 2 * SHM_V;
    constexpr int ND = SOLO ? 1 : 4;
    float m_reg = -1e30f, l_reg = 0; f32x16 o[ND] = {};
    const int sr = tid >> 4, sc = (tid & 15) * 8, vst0 = v_st(sr, sc), kws = KSWZ(sr, sc * 2);
    const unsigned rofs = (unsigned)(sr * KP + sc) * (unsigned)sizeof(TKV);
    const int vb0 = (int)(uintptr_t)V_lds + v_rd_base(lane) + (SOLO ? (wid & 3) * 512 : 0);
    const float cqv = cur.CQ[wq * QBLK + r32];
#define RESC(a) do { if (__any((a) < 1.f)) { for (int d_ = 0; d_ < ND; ++d_) for (int r = 0; r < 16; ++r) o[d_][r] *= (a); } } while (0)
#define KBASE(t) ((j_lo + (t)) * KVBLK)
#define MASKT(P0_, P1_, t) do { const int kb_ = KBASE(t); if (wact && kb_ + KVBLK - 1 > qlo) mask_tile(P0_, P1_, qm - kb_); } while (0)
#define LOADCK(P0_, P1_, t) do { if (wact) loadck(P0_, P1_, cur.CK, KBASE(t) + 4 * hi); } while (0)
    constexpr int NQL = 8;
#define SEAM_K0() do { VMWN(NQL); if constexpr (F32) { SWRITE_KF(0); SBAR(); SLOAD_FV(nxt, kbn); } else { SWRITE_HK(0); } SBAR(); } while (0)
    f32x16 pA0, pA1, pB0, pB1; float mnA, mnB, alA, alB; bf16x8 pa0, pa1, pa2, pa3;
    LOADCK(pA0, pA1, 0);
    if constexpr (F32) { VMW(); SWRITE_VF(0); SBAR(); } else { SWRITE_HV(0); SBAR(); }
    if (NT > 1) { if constexpr (F32) SLOAD_FK(cur, KBASE(1)); else SLOAD_H(cur, KBASE(1)); }
    SBAR(); qkt<0, SK>(pA0, pA1, K_lds, r32, hi, S.qr, cqv, wact);
    if (NT > 1) { LOADCK(pB0, pB1, 1); SBAR(); }
    if constexpr (F32) { if (NT > 1) { VMW(); SWRITE_KF(1); SBAR(); SLOAD_FV(cur, KBASE(1)); } }
    MASKT(pA0, pA1, 0); partialSM(pA0, pA1, m_reg, mnA, alA);
    if (NT > 1) { VMW(); if constexpr (F32) { SWRITE_VF(1); SBAR(); if (NT > 2) SLOAD_FK(cur, KBASE(2)); } else SWRITE_H(1); }
    __syncthreads();
#define HALF_STEP(PX0, PX1, mnX, alX, PY0, PY1, alY, t, KB, VB, SB) do {                                                      \
        SBAR(); qkt<KB, SK>(PX0, PX1, K_lds, r32, hi, S.qr, cqv, wact);                                                       \
        finishSM(PY0, PY1, alY, l_reg, pa0, pa1, pa2, pa3); SBAR();                                                           \
        if ((t) + 1 < NT) { if constexpr (F32) { VMW(); SWRITE_KF(SB); SBAR(); SLOAD_FV(cur, KBASE((t) + 1)); }               \
                            else { SLOAD_H(cur, KBASE((t) + 1)); } SBAR(); LOADCK(PY0, PY1, (t) + 1); SBAR(); }               \
        pv_tile<VB, ND>(o, vb0, pa0, pa1, pa2, pa3); MASKT(PX0, PX1, (t)); partialSM(PX0, PX1, m_reg, mnX, alX);        \
        __syncthreads();                                                                                                      \
        if ((t) + 1 < NT) { VMW(); if constexpr (F32) { SWRITE_VF(SB); SBAR(); if ((t) + 2 < NT) SLOAD_FK(cur, KBASE((t) + 2)); } \
                            else { SWRITE_H(SB); } }                                                                          \
        RESC(alX); __syncthreads(); } while (0)
    for (int t = 1; t + 1 < NT; t += 2) {
        HALF_STEP(pB0, pB1, mnB, alB, pA0, pA1, alA, t, 1, 0, 0);
        HALF_STEP(pA0, pA1, mnA, alA, pB0, pB1, alB, t + 1, 0, 1, 1);
    }
    const bool even = (NT & 1) == 0;
    if (even) { SBAR(); qkt<1, SK>(pB0, pB1, K_lds, r32, hi, S.qr, cqv, wact); SBAR(); }
    if constexpr (F32) { SLOAD_FK(nxt, kbn); SBAR(); } else { SLOAD_H(nxt, kbn); SBAR(); }
    { const int wqn = SOLO ? 0 : wid;
#pragma unroll
      for (int d0 = 0; d0 < 8; ++d0) S.qr[d0] = ld8h(nxt.Q + (size_t)(wqn * QBLK + r32) * QP + d0 * 16 + hi * 8); }
    SBAR();
    finishSM(pA0, pA1, alA, l_reg, pa0, pa1, pa2, pa3); SBAR();
    pv_tile<0, ND>(o, vb0, pa0, pa1, pa2, pa3);
    if (even) { MASKT(pB0, pB1, NT - 1); partialSM(pB0, pB1, m_reg, mnB, alB); __syncthreads(); RESC(alB);
        finishSM(pB0, pB1, alB, l_reg, pa0, pa1, pa2, pa3); SBAR(); pv_tile<1, ND>(o, vb0, pa0, pa1, pa2, pa3); }
    SBAR(); SEAM_K0();
    if (!SOLO || wid < 4) {
        const float inv = __builtin_amdgcn_rcpf(l_reg);
        const int cb = SOLO ? (wid & 3) * 32 : 0;
        bf16* Ow = cur.O + (size_t)(wq * QBLK + r32) * OP + 4 * hi + cb; const bf16* Gw = cur.G + (size_t)(wq * QBLK + r32) * GPI + 4 * hi + cb;
#pragma unroll
        for (int d0 = 0; d0 < ND; ++d0) {
#pragma unroll
            for (int g = 0; g < 4; ++g) { const uint2 gt = *(const uint2*)(Gw + d0 * 32 + 8 * g);
                uint2 w; w.x = cvtpk(o[d0][4 * g] * inv * __uint_as_float(gt.x << 16), o[d0][4 * g + 1] * inv * __uint_as_float(gt.x & 0xffff0000u));
                w.y = cvtpk(o[d0][4 * g + 2] * inv * __uint_as_float(gt.y << 16), o[d0][4 * g + 3] * inv * __uint_as_float(gt.y & 0xffff0000u));
                *(uint2*)(Ow + d0 * 32 + 8 * g) = w; }
            asm volatile("" ::: "memory"); }
    }
    __syncthreads();
#undef RESC
#undef KBASE
#undef MASKT
#undef LOADCK
#undef SEAM_K0
#undef HALF_STEP
}
#undef TBASE
#undef VMW
#undef VMWN
#undef SLOAD_H
#undef SWRITE_HK
#undef SWRITE_HV
#undef SWRITE_H
#undef SLOAD_FK
#undef SLOAD_FV
#undef SWRITE_KF
#undef SWRITE_VF
}

constexpr int DM = 2048, NB = 4, SEQ = 8192, DECB = 32, DECS = 32, PAST = 4096, NH = 8, HD = 128, DATT = 1024, DSSM = 1024, NG = 64, NST = 64, DPLE = 256;
constexpr int MP = NB * SEQ, MS = DECB * DECS, MT = MP + MS;
constexpr int DIN = 6152, OFF_F = 3072;
constexpr int NIN = 6144;
constexpr int CHUNK = 32, NCH = MT / CHUNK, UHROWS = NCH, UHLD = 640;
constexpr int NSSM_ITEMS = NG * 5;
constexpr int CSLD = 4160;
constexpr float EPS = 1e-6f;
constexpr size_t O_YP = 0, O_YS = O_YP + (size_t)MP * DM, O_KP = O_YS + (size_t)MS * DM, O_VP = O_KP + (size_t)MP * DATT, O_LFP = O_VP + (size_t)MP * DATT,
                 O_SRP = O_LFP + (size_t)MP * NH, O_SIP = O_SRP + NB * NG * NST, O_KS = O_SIP + NB * NG * NST, O_VS = O_KS + (size_t)MS * DATT, O_LFS = O_VS + (size_t)MS * DATT,
                 O_SRS = O_LFS + (size_t)MS * NH, O_SIS = O_SRS + DECB * NG * NST, O_END = O_SIS + DECB * NG * NST;
constexpr size_t MiB = 1u << 20;
constexpr size_t WS_CTL = 0, CTL_ZERO_BYTES = 1 * MiB;
constexpr size_t WS_WIN_T = 1 * MiB, WS_WGLU_T = 25 * MiB, WS_WOUT_T = 27 * MiB, WS_WPE_T = 35 * MiB, WS_WPG_T = 36 * MiB;
constexpr size_t WS_MW_T = 44 * MiB, WS_BP_T = 84 * MiB, WS_A32 = 100 * MiB, WS_LOGF = 101 * MiB, WS_CP = 103 * MiB, WS_CS = 104 * MiB;
constexpr size_t WS_ESS = 109 * MiB, WS_H2SS = 114 * MiB, WS_RSTDE = 119 * MiB;
constexpr size_t WS_XN = 120 * MiB, WS_PB = 252 * MiB, WS_Q = 270 * MiB, WS_K = 336 * MiB, WS_V = 402 * MiB, WS_SGA = 468 * MiB, WS_SGS = 534 * MiB;
constexpr size_t WS_UH = 600 * MiB, WS_SBUF = 684 * MiB, WS_YACT = 724 * MiB, WS_MIXED = 790 * MiB, WS_HB = 922 * MiB, WS_E = 1054 * MiB, WS_END = 1186 * MiB;
constexpr size_t WS_GP = 1200 * MiB;
static_assert(WS_LOGF + (size_t)MT * 8 * 4 <= WS_CP && WS_CS + (size_t)DECB * NH * CSLD * 4 <= WS_ESS && WS_ESS + (size_t)MT * 32 * 4 <= WS_H2SS && WS_H2SS + (size_t)MT * 32 * 4 <= WS_RSTDE, "ws map a");
static_assert(WS_XN + (size_t)MT * DM * 2 <= WS_PB && WS_PB + (size_t)MT * DPLE * 2 <= WS_Q && WS_Q + (size_t)MT * DATT * 2 <= WS_K && WS_UH + (size_t)(NG * UHROWS + 256) * UHLD * 2 <= WS_SBUF, "ws map b");
static_assert(WS_SBUF + (size_t)NSSM_ITEMS * 256 * 128 * 4 <= WS_YACT && WS_YACT + (size_t)MT * DSSM * 2 <= WS_MIXED && WS_MIXED + (size_t)MT * DM * 2 <= WS_HB && WS_E + (size_t)MT * DM * 2 <= WS_END, "ws map c");
constexpr int CW_TMO = 0, CW_BAR = 4096;

constexpr int NWAVES = 8, NTHR = 512;
constexpr int RING_OFF = 0, RING_BYTES = 131072, LDSCTL_OFF = RING_BYTES, MISC_OFF = LDSCTL_OFF + 320, LDS_BYTES = 147456;

#define GAS __attribute__((address_space(1)))
#define LAS __attribute__((address_space(3)))
typedef unsigned short bf16;
typedef unsigned v4u __attribute__((ext_vector_type(4)));
typedef unsigned v2u __attribute__((ext_vector_type(2)));
typedef float f32x4 __attribute__((ext_vector_type(4)));
typedef float f32x2 __attribute__((ext_vector_type(2)));
#define LDS_WAIT() asm volatile("s_waitcnt lgkmcnt(0)" ::: "memory")
#define VM_WAIT() asm volatile("s_waitcnt vmcnt(0)" ::: "memory")
__device__ __forceinline__ unsigned f2bf(float f) { unsigned u = __builtin_bit_cast(unsigned, f); return (u + 0x7fffu + ((u >> 16) & 1u)) >> 16; }
__device__ __forceinline__ unsigned pk2(float lo, float hi) { return f2bf(lo) | (f2bf(hi) << 16); }
__device__ __forceinline__ float wave_sum(float v) {
#pragma unroll
    for (int o = 1; o < 64; o <<= 1) v += __shfl_xor(v, o);
    return v;
}

#define XB_TMO      128
#define XB_XCNT(j)  (256  + 64 * (j))
#define XB_XSUB(j)  (1280 + 64 * (j))
#define XB_XGEN(j)  (2304 + 64 * (j))
#define XB_TOP      3328
#define XB_TOPGEN   3392
#define XCD_BAR_WORDS 3456
#define XB_SPIN_CAP (1u << 22)
__device__ __forceinline__ unsigned xb_ld(unsigned* p)              { return __hip_atomic_load(p, __ATOMIC_RELAXED, __HIP_MEMORY_SCOPE_AGENT); }
__device__ __forceinline__ unsigned xb_add(unsigned* p, unsigned v) { return __hip_atomic_fetch_add(p, v, __ATOMIC_RELAXED, __HIP_MEMORY_SCOPE_AGENT); }
__device__ __forceinline__ unsigned xb_xcc_id() { return (unsigned)__builtin_amdgcn_s_getreg((3 << 11) | 20) & 0xFu; }
#define XB_SPIN(cond, bar) do { unsigned _sp = 0; while (cond) { __builtin_amdgcn_s_sleep(1); \
    if ((++_sp & 255u) == 0u) { if (xb_ld(&(bar)[XB_TMO])) break; if (_sp > XB_SPIN_CAP) { atomicAdd(&(bar)[XB_TMO], 1u); break; } } } } while (0)
struct XcdBarrier { unsigned* bar; unsigned x; volatile LAS unsigned* st; };
__device__ __forceinline__ XcdBarrier xcd_barrier_post(unsigned* bar, volatile LAS unsigned* st) {
    XcdBarrier b; b.bar = bar; b.x = xb_xcc_id(); b.st = st;
    if (threadIdx.x == 0) (void)xb_add(&bar[XB_XCNT(b.x)], 1u);
    return b;
}
__device__ __forceinline__ void xcd_barrier_complete(unsigned* bar, unsigned x, unsigned& nloc, unsigned& nx) {
    const unsigned G = gridDim.x * gridDim.y * gridDim.z;
    unsigned sum, cnt, mine, sp = 0u;
    for (;;) {
        sum = 0u; cnt = 0u; mine = 0u;
#pragma unroll
        for (unsigned j = 0; j < 16; ++j) { const unsigned c = xb_ld(&bar[XB_XCNT(j)]); sum += c; cnt += (c > 0u) ? 1u : 0u; mine = (j == x) ? c : mine; }
        if (sum == G) break;
        __builtin_amdgcn_s_sleep(1);
        if ((++sp & 255u) == 0u) { if (xb_ld(&bar[XB_TMO])) break; if (sp > XB_SPIN_CAP) { atomicAdd(&bar[XB_TMO], 1u); break; } }
    }
    nloc = mine > 0u ? mine : 1u; nx = cnt > 0u ? cnt : 1u;
}
__device__ __forceinline__ void xcd_barrier(const XcdBarrier& b) {
    asm volatile("s_waitcnt vmcnt(0)" ::: "memory");
    __syncthreads();
    if (threadIdx.x == 0) {
        unsigned* bar = b.bar;
        __builtin_amdgcn_s_waitcnt(0);
        unsigned nloc = b.st[0], nx = b.st[1];
        if (nloc == 0u) { xcd_barrier_complete(bar, b.x, nloc, nx); b.st[0] = nloc; b.st[1] = nx; }
        const unsigned old = xb_add(&bar[XB_XSUB(b.x)], 1u);
        const unsigned gen = old / nloc;
        if (old + 1u == (gen + 1u) * nloc) {
            __builtin_amdgcn_fence(__ATOMIC_RELEASE, "agent");
            asm volatile("s_waitcnt vmcnt(0)" ::: "memory");
            const unsigned og = xb_add(&bar[XB_TOP], 1u);
            const unsigned tg = og / nx;
            if (og + 1u == (tg + 1u) * nx) xb_add(&bar[XB_TOPGEN], 1u);
            else XB_SPIN(xb_ld(&bar[XB_TOPGEN]) == tg, bar);
            __builtin_amdgcn_fence(__ATOMIC_ACQUIRE, "agent");
            xb_add(&bar[XB_XGEN(b.x)], 1u);
            asm volatile("s_waitcnt vmcnt(0)" ::: "memory");
        } else {
            XB_SPIN(xb_ld(&bar[XB_XGEN(b.x)]) == gen, bar);
            __builtin_amdgcn_fence(__ATOMIC_ACQUIRE, "agent");
            asm volatile("s_waitcnt vmcnt(0)" ::: "memory");
        }
    }
    __syncthreads();
}

enum { I_XP = 0, I_XS, I_PP, I_PS, I_CK, I_CV, I_CLF, I_SRE, I_SIM, I_GIN, I_WIN, I_BF, I_ARE, I_AIM, I_LDT, I_BRE, I_BIM, I_CRE, I_CIM, I_DSK, I_WGLU, I_WOUT, I_WPE, I_GPE, I_WPG, I_GFIN, N_IN };
struct Args { const float* in[N_IN]; float* out; unsigned char* ws; int ph_lo, ph_hi; };
typedef const __attribute__((address_space(4))) Args* KArgs;
__device__ __forceinline__ KArgs launder_kernarg() { KArgs p = (KArgs)__builtin_amdgcn_kernarg_segment_ptr(); asm volatile("" : "+s"(p)); return p; }

using pg8::Unit; using pg8::BM; using pg8::HALF; using pg8::cvt_pk_bf16; using pg8::pack8f; using pg8::bf_lo; using pg8::bf_hi; using pg8::sigmoidf_; using pg8::siluf_; using pg8::gelu_tanh_;
#define EPI_ARGS const f32x4 (&acc)[2][2][4][2], const Unit& u, int wr, int wc, int fr, int fq
struct EpiInProj { static constexpr bool PERM = true, AFTER_DRAIN = false;
    bf16 *Q, *K, *V, *SGA, *SGS, *UH; float *kp, *vp, *ks, *vs;
    __device__ __forceinline__ void operator()(EPI_ARGS) const {
        const int seg = u.pn >> 2, csb = (u.pn & 3) * 256 + wc * 32 + 8 * fq, row0 = u.pm * BM + wr * 64 + fr;
        if (seg == 0 || seg == 3 || seg == 5) {
            bf16* dst = seg == 0 ? Q : (seg == 3 ? SGA : SGS);
#pragma unroll
            for (int ai = 0; ai < 2; ++ai)
#pragma unroll
                for (int m = 0; m < 4; ++m) { bf16* rowp = dst + (size_t)(row0 + ai * HALF + m * 16) * 1024 + csb;
#pragma unroll
                    for (int bj = 0; bj < 2; ++bj) { f32x4 v0 = acc[ai][bj][m][0], v1 = acc[ai][bj][m][1];
                        if (seg != 0) { for (int i = 0; i < 4; ++i) { v0[i] = siluf_(v0[i]); v1[i] = siluf_(v1[i]); } }
                        *(v4u*)(rowp + bj * HALF) = pack8f(v0, v1); } }
        } else if (seg == 1 || seg == 2) {
            bf16* dst = seg == 1 ? K : V; float* o32 = u.pm < MP / BM ? (seg == 1 ? kp : vp) : (seg == 1 ? ks : vs) - (size_t)MP * 1024;
#pragma unroll
            for (int ai = 0; ai < 2; ++ai)
#pragma unroll
                for (int m = 0; m < 4; ++m) { const size_t ro = (size_t)(row0 + ai * HALF + m * 16) * 1024 + csb;
#pragma unroll
                    for (int bj = 0; bj < 2; ++bj) { const f32x4 v0 = acc[ai][bj][m][0], v1 = acc[ai][bj][m][1];
                        *(v4u*)(dst + ro + bj * HALF) = pack8f(v0, v1); *(f32x4*)(o32 + ro + bj * HALF) = v0; *(f32x4*)(o32 + ro + bj * HALF + 4) = v1; } }
        } else {
#pragma unroll
            for (int ai = 0; ai < 2; ++ai)
#pragma unroll
                for (int m = 0; m < 4; ++m) { const int row = row0 + ai * HALF + m * 16, chunk = row >> 5, s = row & 31;
#pragma unroll
                    for (int bj = 0; bj < 2; ++bj) { const int cs = csb + bj * HALF, g = cs >> 4, c0 = cs & 15;
                        *(v4u*)(UH + ((size_t)g * UHROWS + chunk) * UHLD + s * 16 + c0) = pack8f(acc[ai][bj][m][0], acc[ai][bj][m][1]); } }
        }
    }
};
struct EpiPle { static constexpr bool PERM = true, AFTER_DRAIN = false;
    bf16* E; float* ESS;
    __device__ __forceinline__ void operator()(EPI_ARGS) const {
        const int col0 = u.pn * BM + wc * 32 + 8 * fq, row0 = u.pm * BM + wr * 64 + fr;
#pragma unroll
        for (int ai = 0; ai < 2; ++ai)
#pragma unroll
            for (int m = 0; m < 4; ++m) { const int row = row0 + ai * HALF + m * 16; float ss = 0.f;
#pragma unroll
                for (int bj = 0; bj < 2; ++bj) { const f32x4 v0 = acc[ai][bj][m][0], v1 = acc[ai][bj][m][1];
                    ss += (v0[0] * v0[0] + v0[1] * v0[1]) + (v0[2] * v0[2] + v0[3] * v0[3]) + (v1[0] * v1[0] + v1[1] * v1[1]) + (v1[2] * v1[2] + v1[3] * v1[3]);
                    *(v4u*)(E + (size_t)row * DM + col0 + bj * HALF) = pack8f(v0, v1); }
                ss += __shfl_xor(ss, 16); ss += __shfl_xor(ss, 32);
                if (fq == 0) ESS[(size_t)row * 32 + u.pn * 4 + wc] = ss; }
    }
};
struct EpiGlu { static constexpr bool PERM = true, AFTER_DRAIN = false;
    const bf16 *YACT, *SGS; bf16* MIXED;
    __device__ __forceinline__ void operator()(EPI_ARGS) const {
        const int col0 = u.pn * BM + wc * 32 + 8 * fq, row0 = u.pm * BM + wr * 64 + fr;
#pragma unroll
        for (int ai = 0; ai < 2; ++ai)
#pragma unroll
            for (int m = 0; m < 4; ++m) { const int row = row0 + ai * HALF + m * 16;
#pragma unroll
                for (int bj = 0; bj < 2; ++bj) { const size_t o = (size_t)row * 1024 + col0 + bj * HALF;
                    const v4u ya = *(const v4u*)(YACT + o), sg = *(const v4u*)(SGS + o); f32x4 v0 = acc[ai][bj][m][0], v1 = acc[ai][bj][m][1];
                    v0[0] = bf_lo(ya.x) * sigmoidf_(v0[0]) * bf_lo(sg.x); v0[1] = bf_hi(ya.x) * sigmoidf_(v0[1]) * bf_hi(sg.x);
                    v0[2] = bf_lo(ya.y) * sigmoidf_(v0[2]) * bf_lo(sg.y); v0[3] = bf_hi(ya.y) * sigmoidf_(v0[3]) * bf_hi(sg.y);
                    v1[0] = bf_lo(ya.z) * sigmoidf_(v1[0]) * bf_lo(sg.z); v1[1] = bf_hi(ya.z) * sigmoidf_(v1[1]) * bf_hi(sg.z);
                    v1[2] = bf_lo(ya.w) * sigmoidf_(v1[2]) * bf_lo(sg.w); v1[3] = bf_hi(ya.w) * sigmoidf_(v1[3]) * bf_hi(sg.w);
                    *(v4u*)(MIXED + (size_t)row * DM + 1024 + col0 + bj * HALF) = pack8f(v0, v1); } }
    }
};
struct EpiOut { static constexpr bool PERM = true, AFTER_DRAIN = false;
    const float *xp, *xs; float *hp, *hs; bf16* HB;
    __device__ __forceinline__ void operator()(EPI_ARGS) const {
        const int col0 = u.pn * BM + wc * 32 + 8 * fq, row0 = u.pm * BM + wr * 64 + fr;
        const bool pr = u.pm < MP / BM; const float* xb = pr ? xp : xs - (size_t)MP * DM; float* hb = pr ? hp : hs - (size_t)MP * DM;
#pragma unroll
        for (int ai = 0; ai < 2; ++ai)
#pragma unroll
            for (int m = 0; m < 4; ++m) { const int row = row0 + ai * HALF + m * 16;
#pragma unroll
                for (int bj = 0; bj < 2; ++bj) { const size_t o = (size_t)row * DM + col0 + bj * HALF;
                    const f32x4 v0 = acc[ai][bj][m][0] + *(const f32x4*)(xb + o), v1 = acc[ai][bj][m][1] + *(const f32x4*)(xb + o + 4);
                    *(f32x4*)(hb + o) = v0; *(f32x4*)(hb + o + 4) = v1; *(v4u*)(HB + o) = pack8f(v0, v1); } }
    }
};
struct EpiPg { static constexpr bool PERM = true, AFTER_DRAIN = false;
    float *hp, *hs; const bf16* E; const float *RSTDE, *gpe; float* H2SS;
    __device__ __forceinline__ void operator()(EPI_ARGS) const {
        const int col0 = u.pn * BM + wc * 32 + 8 * fq, row0 = u.pm * BM + wr * 64 + fr;
        float* hb = u.pm < MP / BM ? hp : hs - (size_t)MP * DM;
        f32x4 gp[2][2];
#pragma unroll
        for (int bj = 0; bj < 2; ++bj) { gp[bj][0] = *(const f32x4*)(gpe + col0 + bj * HALF); gp[bj][1] = *(const f32x4*)(gpe + col0 + bj * HALF + 4); }
#pragma unroll
        for (int ai = 0; ai < 2; ++ai)
#pragma unroll
            for (int m = 0; m < 4; ++m) { const int row = row0 + ai * HALF + m * 16; const float rs = RSTDE[row]; float ss = 0.f;
#pragma unroll
                for (int bj = 0; bj < 2; ++bj) { const size_t o = (size_t)row * DM + col0 + bj * HALF;
                    const v4u e = *(const v4u*)(E + o); const f32x4 h0 = *(const f32x4*)(hb + o), h1 = *(const f32x4*)(hb + o + 4); const f32x4 a0 = acc[ai][bj][m][0], a1 = acc[ai][bj][m][1];
                    f32x4 v0, v1;
                    v0[0] = h0[0] + bf_lo(e.x) * rs * gp[bj][0][0] * sigmoidf_(a0[0]); v0[1] = h0[1] + bf_hi(e.x) * rs * gp[bj][0][1] * sigmoidf_(a0[1]);
                    v0[2] = h0[2] + bf_lo(e.y) * rs * gp[bj][0][2] * sigmoidf_(a0[2]); v0[3] = h0[3] + bf_hi(e.y) * rs * gp[bj][0][3] * sigmoidf_(a0[3]);
                    v1[0] = h1[0] + bf_lo(e.z) * rs * gp[bj][1][0] * sigmoidf_(a1[0]); v1[1] = h1[1] + bf_hi(e.z) * rs * gp[bj][1][1] * sigmoidf_(a1[1]);
                    v1[2] = h1[2] + bf_lo(e.w) * rs * gp[bj][1][2] * sigmoidf_(a1[2]); v1[3] = h1[3] + bf_hi(e.w) * rs * gp[bj][1][3] * sigmoidf_(a1[3]);
                    ss += (v0[0] * v0[0] + v0[1] * v0[1]) + (v0[2] * v0[2] + v0[3] * v0[3]) + (v1[0] * v1[0] + v1[1] * v1[1]) + (v1[2] * v1[2] + v1[3] * v1[3]);
                    *(f32x4*)(hb + o) = v0; *(f32x4*)(hb + o + 4) = v1; }
                ss += __shfl_xor(ss, 16); ss += __shfl_xor(ss, 32);
                if (fq == 0) H2SS[(size_t)row * 32 + u.pn * 4 + wc] = ss; }
    }
};
struct EpiSsmS { static constexpr bool PERM = false, AFTER_DRAIN = false;
    float* SBUF;
    __device__ __forceinline__ void operator()(EPI_ARGS) const {
        float* base = SBUF + (size_t)(u.g * 5 + u.pm) * 256 * 128; const int col0 = wc * 32 + 4 * fq, row0 = wr * 64 + fr;
#pragma unroll
        for (int ai = 0; ai < 2; ++ai)
#pragma unroll
            for (int m = 0; m < 4; ++m)
#pragma unroll
                for (int n = 0; n < 2; ++n) *(f32x4*)(base + (size_t)(row0 + ai * HALF + m * 16) * 128 + col0 + n * 16) = acc[ai][0][m][n];
    }
};
struct EpiSsmY { static constexpr bool PERM = true, AFTER_DRAIN = false;
    bf16* YACT;
    __device__ __forceinline__ void operator()(EPI_ARGS) const {
        const int n0 = u.pn * BM + wc * 32 + 8 * fq, row0 = wr * 64 + fr;
#pragma unroll
        for (int ai = 0; ai < 2; ++ai)
#pragma unroll
            for (int m = 0; m < 4; ++m) { const int r = row0 + ai * HALF + m * 16;
                if (u.pm < 4 || r < DECB) {
#pragma unroll
                    for (int bj = 0; bj < 2; ++bj) { const int n = n0 + bj * HALF, s = n >> 4, c0 = n & 15; const int tok = (u.pm < 4 ? u.pm * SEQ : MP) + r * CHUNK + s;
                        f32x4 v0 = acc[ai][bj][m][0], v1 = acc[ai][bj][m][1];
                        for (int i = 0; i < 4; ++i) { v0[i] = gelu_tanh_(v0[i]); v1[i] = gelu_tanh_(v1[i]); }
                        *(v4u*)(YACT + (size_t)tok * DSSM + u.g * 16 + c0) = pack8f(v0, v1); } } }
    }
};
struct SsmSched { const bf16* UH; const bf16* Bt; size_t bgrp, btile; int it0, it1, nit, upi;
    __device__ bool next(int i, Unit& u) const { if (i >= nit * upi) return false; const int li = i / upi, item = li == 0 ? it0 : it1; u.g = item / 5; u.pm = item % 5; u.pn = i % upi; return true; }
    __device__ __forceinline__ const char* a_ptr(const Unit& u) const { return (const char*)(UH + ((size_t)u.g * UHROWS + (size_t)u.pm * 256) * UHLD); }
    __device__ __forceinline__ const char* b_ptr(const Unit& u) const { return (const char*)Bt + (size_t)u.g * bgrp + (size_t)u.pn * btile; }
    __device__ __forceinline__ void a_ready(const Unit&) const {}
    __device__ __forceinline__ void done(const Unit&) const {}
};

__device__ __forceinline__ void p0_transpose_item(const float* W, int ldw, int src_col0, bf16* WT, int K, int dst_row0, int k0, LAS float* scr, int lane) {
#pragma unroll 8
    for (int i = 0; i < 32; ++i) { const int kk = 2 * i + (lane >> 5); scr[kk * 33 + (lane & 31)] = W[(size_t)(k0 + kk) * ldw + src_col0 + (lane & 31)]; }
    LDS_WAIT(); asm volatile("" ::: "memory");
    const int c = lane & 7;
#pragma unroll
    for (int j = 0; j < 4; ++j) { const int n = (lane >> 3) + 8 * j; const LAS float* s = scr + (8 * c) * 33 + n;
        v4u o; o.x = pk2(s[0 * 33], s[1 * 33]); o.y = pk2(s[2 * 33], s[3 * 33]); o.z = pk2(s[4 * 33], s[5 * 33]); o.w = pk2(s[6 * 33], s[7 * 33]);
        *(GAS v4u*)(WT + (size_t)(dst_row0 + n) * K + k0 + 8 * c) = o; }
    LDS_WAIT(); asm volatile("" ::: "memory");
}
__device__ __forceinline__ void ssm_tables(KArgs a, LAS unsigned char* lds, int g) {
    const int tid = threadIdx.x;
    LAS float* bbr = (LAS float*)lds;
    LAS float* bbi = bbr + 1024;
    LAS float* Cr = bbi + 1024;
    LAS float* Ci = Cr + 1024;
    LAS float* apr = Ci + 1024;
    LAS float* api = apr + 33 * 64;
    LAS float* Kc = api + 33 * 64;
    if (tid < 64) { const int p = tid;
        const double dt = exp((double)a->in[I_LDT][g]);
        const double ar = a->in[I_ARE][g * 64 + p], ai = a->in[I_AIM][g * 64 + p];
        const double mag = exp(ar * dt), ang = ai * dt; const double abr = mag * cos(ang), abi = mag * sin(ang);
        const double nr = abr - 1.0, ni = abi, den = ar * ar + ai * ai; const double cr = (nr * ar + ni * ai) / den, ci = (ni * ar - nr * ai) / den;
        for (int c = 0; c < 16; ++c) { const double br = a->in[I_BRE][(size_t)(g * 64 + p) * 16 + c], bi = a->in[I_BIM][(size_t)(g * 64 + p) * 16 + c];
            bbr[p * 16 + c] = (float)(cr * br - ci * bi); bbi[p * 16 + c] = (float)(cr * bi + ci * br); }
        double pr = 1.0, pi = 0.0;
        for (int t = 0; t <= 32; ++t) { apr[t * 64 + p] = (float)pr; api[t * 64 + p] = (float)pi; const double nr2 = pr * abr - pi * abi, ni2 = pr * abi + pi * abr; pr = nr2; pi = ni2; }
        float* A32 = (float*)(a->ws + WS_A32); A32[(g * 64 + p) * 2] = apr[32 * 64 + p]; A32[(g * 64 + p) * 2 + 1] = api[32 * 64 + p];
    }
    for (int e = tid; e < 1024; e += NTHR) { Cr[e] = a->in[I_CRE][(size_t)g * 1024 + e]; Ci[e] = a->in[I_CIM][(size_t)g * 1024 + e]; }
    __syncthreads();
    for (int e = tid; e < 8192; e += NTHR) { const int t = e >> 8, c = (e >> 4) & 15, c2 = e & 15; float sum = 0.f;
        for (int p = 0; p < 64; ++p) { const float car = Cr[c * 64 + p] * apr[t * 64 + p] - Ci[c * 64 + p] * api[t * 64 + p], cai = Cr[c * 64 + p] * api[t * 64 + p] + Ci[c * 64 + p] * apr[t * 64 + p];
            sum += car * bbr[p * 16 + c2] - cai * bbi[p * 16 + c2]; }
        if (t == 0 && c == c2) sum += a->in[I_DSK][g * 16 + c];
        Kc[e] = sum; }
    __syncthreads();
    bf16* MW = (bf16*)(a->ws + WS_MW_T) + (size_t)g * 512 * UHLD;
    for (int idx = tid; idx < 512 * 80; idx += NTHR) { const int n = idx / 80, k0 = (idx % 80) * 8, s = n >> 4, c = n & 15; float v[8];
        if (k0 < 512) { const int s2 = k0 >> 4, c0 = k0 & 15;
#pragma unroll
            for (int j = 0; j < 8; ++j) v[j] = s2 <= s ? Kc[((s - s2) * 16 + c) * 16 + c0 + j] : 0.f;
        } else if (k0 < 576) {
#pragma unroll
            for (int j = 0; j < 8; ++j) { const int p = k0 - 512 + j; v[j] = Cr[c * 64 + p] * apr[(s + 1) * 64 + p] - Ci[c * 64 + p] * api[(s + 1) * 64 + p]; }
        } else {
#pragma unroll
            for (int j = 0; j < 8; ++j) { const int p = k0 - 576 + j; v[j] = -(Cr[c * 64 + p] * api[(s + 1) * 64 + p] + Ci[c * 64 + p] * apr[(s + 1) * 64 + p]); }
        }
        v4u o; o.x = pk2(v[0], v[1]); o.y = pk2(v[2], v[3]); o.z = pk2(v[4], v[5]); o.w = pk2(v[6], v[7]);
        *(GAS v4u*)(MW + (size_t)n * UHLD + k0) = o; }
    bf16* BP = (bf16*)(a->ws + WS_BP_T) + (size_t)g * 256 * 512;
    for (int idx = tid; idx < 256 * 64; idx += NTHR) { const int n = idx >> 6, k0 = (idx & 63) * 8, s2 = k0 >> 4, c0 = k0 & 15; float v[8];
#pragma unroll
        for (int j = 0; j < 8; ++j) {
            if (n < 64) v[j] = apr[(31 - s2) * 64 + n] * bbr[n * 16 + c0 + j] - api[(31 - s2) * 64 + n] * bbi[n * 16 + c0 + j];
            else if (n < 128) { const int p = n - 64; v[j] = apr[(31 - s2) * 64 + p] * bbi[p * 16 + c0 + j] + api[(31 - s2) * 64 + p] * bbr[p * 16 + c0 + j]; }
            else v[j] = 0.f; }
        v4u o; o.x = pk2(v[0], v[1]); o.y = pk2(v[2], v[3]); o.z = pk2(v[4], v[5]); o.w = pk2(v[6], v[7]);
        *(GAS v4u*)(BP + (size_t)n * 512 + k0) = o; }
    __syncthreads();
}
__device__ __forceinline__ float log_sigmoid_(float z) { return z >= 0.f ? -log1pf(expf(-z)) : z - log1pf(expf(z)); }
__device__ __forceinline__ void phase0(KArgs a, LAS unsigned char* lds) {
    const int tid = threadIdx.x, lane = tid & 63, wave = __builtin_amdgcn_readfirstlane(tid >> 6);
    const int gw = blockIdx.x * NWAVES + wave, NGW = gridDim.x * NWAVES;
    if (blockIdx.x < NG) ssm_tables(a, lds, blockIdx.x);
    { LAS float* scr = (LAS float*)(lds + wave * 16384);
      constexpr int I_IN = 32 * 192, I_GLU = 16 * 32, I_OUT = 32 * 64, I_PE = 4 * 64, I_PG = 32 * 64, NITEMS = I_IN + I_GLU + I_OUT + I_PE + I_PG;
      for (int it = gw; it < NITEMS; it += NGW) { int r = it;
          if (r < I_IN) { const int kb = r / 192, nb = r % 192; p0_transpose_item(a->in[I_WIN], DIN, 32 * nb + (nb >= 96 ? 8 : 0), (bf16*)(a->ws + WS_WIN_T), DM, 32 * nb, 64 * kb, scr, lane); continue; } r -= I_IN;
          if (r < I_GLU) { const int kb = r / 32, nb = r % 32; p0_transpose_item(a->in[I_WGLU], DSSM, 32 * nb, (bf16*)(a->ws + WS_WGLU_T), DSSM, 32 * nb, 64 * kb, scr, lane); continue; } r -= I_GLU;
          if (r < I_OUT) { const int kb = r / 64, nb = r % 64; p0_transpose_item(a->in[I_WOUT], DM, 32 * nb, (bf16*)(a->ws + WS_WOUT_T), DM, 32 * nb, 64 * kb, scr, lane); continue; } r -= I_OUT;
          if (r < I_PE) { const int kb = r / 64, nb = r % 64; p0_transpose_item(a->in[I_WPE], DM, 32 * nb, (bf16*)(a->ws + WS_WPE_T), DPLE, 32 * nb, 64 * kb, scr, lane); continue; } r -= I_PE;
          { const int kb = r / 64, nb = r % 64; p0_transpose_item(a->in[I_WPG], DM, 32 * nb, (bf16*)(a->ws + WS_WPG_T), DM, 32 * nb, 64 * kb, scr, lane); } } }
    __syncthreads();
    LAS float* wfT = (LAS float*)lds;
    for (int e = tid; e < DM * NH; e += NTHR) { const int k = e >> 3, h = e & 7; wfT[h * DM + k] = a->in[I_WIN][(size_t)k * DIN + OFF_F + h]; }
    __syncthreads();
    f32x4 gi[8];
#pragma unroll
    for (int j = 0; j < 8; ++j) gi[j] = *(const f32x4*)(a->in[I_GIN] + 256 * j + 4 * lane);
    const float bfh = a->in[I_BF][lane & 7];
    float* LOGF = (float*)(a->ws + WS_LOGF);
    for (int row = gw; row < MT; row += NGW) {
        const bool pr = row < MP;
        const float* xr = pr ? a->in[I_XP] + (size_t)row * DM : a->in[I_XS] + (size_t)(row - MP) * DM;
        f32x4 v[8]; float ss = 0.f;
#pragma unroll
        for (int j = 0; j < 8; ++j) { v[j] = *(const f32x4*)(xr + 256 * j + 4 * lane); ss += (v[j][0] * v[j][0] + v[j][1] * v[j][1]) + (v[j][2] * v[j][2] + v[j][3] * v[j][3]); }
        const float rstd = 1.0f / sqrtf(wave_sum(ss) * (1.0f / DM) + EPS);
        bf16* xo = (bf16*)(a->ws + WS_XN) + (size_t)row * DM;
#pragma unroll
        for (int j = 0; j < 8; ++j) { v[j] = v[j] * rstd * gi[j]; v2u w; w.x = pk2(v[j][0], v[j][1]); w.y = pk2(v[j][2], v[j][3]); *(GAS v2u*)(xo + 256 * j + 4 * lane) = w; }
        float mine = 0.f;
#pragma unroll 1
        for (int h = 0; h < 8; ++h) { float s = 0.f;
#pragma unroll
            for (int j = 0; j < 8; ++j) { const f32x4 w = *(const LAS f32x4*)(wfT + h * DM + 256 * j + 4 * lane); s += (v[j][0] * w[0] + v[j][1] * w[1]) + (v[j][2] * w[2] + v[j][3] * w[3]); }
            s = wave_sum(s); mine = (lane & 7) == h ? s : mine; }
        if (lane < 8) { const float lf = log_sigmoid_(mine + bfh); LOGF[(size_t)row * 8 + lane] = lf;
            (pr ? a->out + O_LFP + (size_t)row * 8 : a->out + O_LFS + (size_t)(row - MP) * 8)[lane] = lf; }
        const float* prow = pr ? a->in[I_PP] + (size_t)row * DPLE : a->in[I_PS] + (size_t)(row - MP) * DPLE;
        const f32x4 pv = *(const f32x4*)(prow + 4 * lane); v2u w; w.x = pk2(pv[0], pv[1]); w.y = pk2(pv[2], pv[3]);
        *(GAS v2u*)((bf16*)(a->ws + WS_PB) + (size_t)row * DPLE + 4 * lane) = w;
    }
}
__device__ __forceinline__ void forget_cumsum(KArgs a, LAS unsigned char* lds) {
    const int bid = blockIdx.x, tid = threadIdx.x;
    if (bid < NB + DECB) {
        LAS double* sseg = (LAS double*)lds;
        const int h = tid & 7, seg = tid >> 3; const float* LOGF = (const float*)(a->ws + WS_LOGF);
        const bool pr = bid < NB; const int b = pr ? bid : bid - NB, n = pr ? SEQ : PAST + DECS, L = pr ? 128 : 65;
        const float* s0 = pr ? LOGF + (size_t)b * SEQ * 8 + h : a->in[I_CLF] + (size_t)b * PAST * 8 + h;
        const float* s1 = LOGF + ((size_t)MP + (size_t)b * DECS) * 8 + h;
        const int n0 = pr ? SEQ : PAST;
        float* out = pr ? (float*)(a->ws + WS_CP) + (size_t)(b * NH + h) * SEQ : (float*)(a->ws + WS_CS) + (size_t)(b * NH + h) * CSLD;
        const int t0 = seg * L, t1 = (t0 + L < n) ? t0 + L : n;
        double s = 0.0;
        for (int t = t0; t < t1; ++t) s += (double)(t < n0 ? s0[(size_t)t * 8] : s1[(size_t)(t - n0) * 8]);
        sseg[seg * 8 + h] = s; __syncthreads();
        double pre = 0.0; for (int j = 0; j < seg; ++j) pre += sseg[j * 8 + h];
        for (int t = t0; t < t1; ++t) { pre += (double)(t < n0 ? s0[(size_t)t * 8] : s1[(size_t)(t - n0) * 8]); out[t] = (float)(pre * 11.313708498984761); }
        if (!pr && seg == 63) { const float last = (float)(pre * 11.313708498984761); for (int t = n; t < CSLD; ++t) out[t] = last; }
        __syncthreads();
    }
}
__device__ __forceinline__ void ssm_scan(KArgs a, int item, int lane) {
    const int g = item / 5, u = item % 5, p = lane;
    const float* S = (const float*)(a->ws + WS_SBUF) + (size_t)item * 256 * 128;
    bf16* UH = (bf16*)(a->ws + WS_UH) + ((size_t)g * UHROWS + (size_t)u * 256) * UHLD;
    const float a32r = ((const float*)(a->ws + WS_A32))[(g * 64 + p) * 2], a32i = ((const float*)(a->ws + WS_A32))[(g * 64 + p) * 2 + 1];
    if (u < 4) {
        float hr = 0.f, hi = 0.f;
        for (int j = 0; j < 256; ++j) {
            UH[(size_t)j * UHLD + 512 + p] = (bf16)f2bf(hr); UH[(size_t)j * UHLD + 576 + p] = (bf16)f2bf(hi);
            const float sr = S[j * 128 + p], si = S[j * 128 + 64 + p];
            const float nr = a32r * hr - a32i * hi + sr, ni = a32r * hi + a32i * hr + si; hr = nr; hi = ni; }
        a->out[O_SRP + (size_t)(u * NG + g) * NST + p] = hr; a->out[O_SIP + (size_t)(u * NG + g) * NST + p] = hi;
    } else {
        for (int j = 0; j < DECB; ++j) {
            const float hr = a->in[I_SRE][(size_t)(j * NG + g) * NST + p], hi = a->in[I_SIM][(size_t)(j * NG + g) * NST + p];
            UH[(size_t)j * UHLD + 512 + p] = (bf16)f2bf(hr); UH[(size_t)j * UHLD + 576 + p] = (bf16)f2bf(hi);
            const float sr = S[j * 128 + p], si = S[j * 128 + 64 + p];
            a->out[O_SRS + (size_t)(j * NG + g) * NST + p] = a32r * hr - a32i * hi + sr; a->out[O_SIS + (size_t)(j * NG + g) * NST + p] = a32r * hi + a32i * hr + si; }
    }
}
__device__ __forceinline__ att::BlockRef<att::bf16> prompt_ref(KArgs a, int bh, int qb) {
    const int b = bh >> 3, h = bh & 7; att::BlockRef<att::bf16> r;
    const size_t row0 = (size_t)b * SEQ + (size_t)qb * 256;
    r.Q = (const bf16*)(a->ws + WS_Q) + row0 * 1024 + h * HD; r.K = (const bf16*)(a->ws + WS_K) + (size_t)b * SEQ * 1024 + h * HD; r.V = (const bf16*)(a->ws + WS_V) + (size_t)b * SEQ * 1024 + h * HD;
    r.Kn = r.K; r.Vn = r.V; r.O = (bf16*)(a->ws + WS_MIXED) + row0 * DM + h * HD; r.G = (const bf16*)(a->ws + WS_SGA) + row0 * 1024 + h * HD;
    r.CK = (const float*)(a->ws + WS_CP) + (size_t)(b * NH + h) * SEQ; r.CQ = r.CK + qb * 256; r.np = 0x7fffffff; r.P0 = qb * 256; r.jlo = 0; r.jhi = 4 * qb + 4;
    return r;
}
__device__ __forceinline__ att::BlockRef<float> sample_ref(KArgs a, int bh) {
    const int b = bh >> 3, h = bh & 7; att::BlockRef<float> r;
    const size_t row0 = (size_t)MP + (size_t)b * DECS;
    r.Q = (const bf16*)(a->ws + WS_Q) + row0 * 1024 + h * HD; r.K = a->in[I_CK] + (size_t)b * PAST * 1024 + h * HD; r.V = a->in[I_CV] + (size_t)b * PAST * 1024 + h * HD;
    r.Kn = a->out + O_KS + (size_t)b * DECS * 1024 + h * HD; r.Vn = a->out + O_VS + (size_t)b * DECS * 1024 + h * HD;
    r.O = (bf16*)(a->ws + WS_MIXED) + row0 * DM + h * HD; r.G = (const bf16*)(a->ws + WS_SGA) + row0 * 1024 + h * HD;
    r.CK = (const float*)(a->ws + WS_CS) + (size_t)(b * NH + h) * CSLD; r.CQ = r.CK + PAST; r.np = PAST; r.P0 = PAST; r.jlo = 0; r.jhi = (PAST + 64) / 64;
    return r;
}

__global__ void __launch_bounds__(NTHR, 2) fox_s5_fwd(Args args) {
    extern __shared__ __attribute__((aligned(16))) unsigned char lds_raw[];
    LAS unsigned char* lds = (LAS unsigned char*)lds_raw;
    const int G = gridDim.x, bid = blockIdx.x;
#define THREAD_IDS() int tid = threadIdx.x; asm volatile("" : "+v"(tid)); const int lane = tid & 63, wave = __builtin_amdgcn_readfirstlane(tid >> 6); (void)lane; (void)wave
    { THREAD_IDS(); for (int u = tid; u < (LDS_BYTES - LDSCTL_OFF) / 4; u += NTHR) ((LAS unsigned*)(lds + LDSCTL_OFF))[u] = 0u; }
    __syncthreads();
#if MK_ONE_LAUNCH
    XcdBarrier bar = xcd_barrier_post((unsigned*)(args.ws + WS_CTL) + CW_BAR, (volatile LAS unsigned*)(lds + MISC_OFF) + 8);
#define GRID_BAR() xcd_barrier(bar)
#else
#define GRID_BAR() do {} while (0)
#endif
    const int lo = args.ph_lo, hi = args.ph_hi;
#ifdef ONLY_PH
#define IN(k) ((k) == ONLY_PH && lo <= (k) && (k) < hi)
#else
#define IN(k) (lo <= (k) && (k) < hi)
#endif
#define BOTH(k) (IN(k) && IN((k) + 1))

    if (IN(0)) { KArgs A = launder_kernarg(); unsigned char* ws = A->ws; (void)ws; phase0(A, lds); if (BOTH(0)) GRID_BAR(); }

    if (IN(1)) { KArgs A = launder_kernarg(); unsigned char* ws = A->ws; (void)ws;
        forget_cumsum(A, lds);
        { pg8::Gemm g{DM, DM, DM}; pg8::StaticOrder S; S.init((const bf16*)(ws + WS_XN), (const bf16*)(ws + WS_WIN_T), DM, DM, MT, NIN, G, bid);
          EpiInProj E{(bf16*)(ws + WS_Q), (bf16*)(ws + WS_K), (bf16*)(ws + WS_V), (bf16*)(ws + WS_SGA), (bf16*)(ws + WS_SGS), (bf16*)(ws + WS_UH),
                      A->out + O_KP, A->out + O_VP, A->out + O_KS, A->out + O_VS};
          pg8::gemm_phase<EpiInProj, pg8::StaticOrder, true, true>(lds + RING_OFF, g, S, E); }
        { pg8::Gemm g{DPLE, DPLE, DPLE}; pg8::StaticOrder S; S.init((const bf16*)(ws + WS_PB), (const bf16*)(ws + WS_WPE_T), DPLE, DPLE, MT, DM, G, bid);
          EpiPle E{(bf16*)(ws + WS_E), (float*)(ws + WS_ESS)};
          pg8::gemm_phase<EpiPle, pg8::StaticOrder, true, true>(lds + RING_OFF, g, S, E); }
        if (BOTH(1)) GRID_BAR();
    }

    if (IN(2)) { KArgs A = launder_kernarg(); unsigned char* ws = A->ws; (void)ws; THREAD_IDS();
#ifndef NO_SSM
        { const int it0 = bid, it1 = bid + G, nit = it0 < NSSM_ITEMS ? (it1 < NSSM_ITEMS ? 2 : 1) : 0;
          if (nit > 0) {
            { pg8::Gemm g{UHLD, 512, 512}; SsmSched S{(const bf16*)(ws + WS_UH), (const bf16*)(ws + WS_BP_T), (size_t)256 * 512 * 2, 0, it0, it1, nit, 1};
              EpiSsmS E{(float*)(ws + WS_SBUF)};
              pg8::gemm_phase<EpiSsmS, SsmSched, false, true>(lds + RING_OFF, g, S, E); }
            VM_WAIT(); __syncthreads();
            if (wave < nit) ssm_scan(A, wave == 0 ? it0 : it1, lane);
            VM_WAIT(); __syncthreads();
            { pg8::Gemm g{UHLD, UHLD, UHLD}; SsmSched S{(const bf16*)(ws + WS_UH), (const bf16*)(ws + WS_MW_T), (size_t)512 * UHLD * 2, (size_t)256 * UHLD * 2, it0, it1, nit, 2};
              EpiSsmY E{(bf16*)(ws + WS_YACT)};
              pg8::gemm_phase<EpiSsmY, SsmSched, false, true>(lds + RING_OFF, g, S, E); }
          } }
#endif
        __syncthreads();
#ifndef NO_PATT
        { att::Seam S; int L = bid;
          if (L < 512) {
            int pass = 0; att::BlockRef<att::bf16> cur = prompt_ref(A, L >> 4, L & 15);
            att::fox_prime<att::bf16, false>(cur, (char*)lds_raw + RING_OFF, S);
            for (;;) {
                int Ln = L, passn = pass + 1; if (pass == 1) { passn = 0; Ln = L + G; }
                const bool last = Ln >= 512;
                const att::BlockRef<att::bf16> nxt = last ? cur : prompt_ref(A, Ln >> 4, passn == 0 ? (Ln & 15) : 31 - (Ln & 15));
                att::fox_block<att::bf16, false>(cur, nxt, (char*)lds_raw + RING_OFF, S);
                if (last) break;
                cur = nxt; L = Ln; pass = passn;
            } } }
#endif
        __syncthreads();
#ifndef NO_SATT
        { att::Seam S;
          for (int L = bid; L < DECB * NH; L += G) {
            const att::BlockRef<float> cur = sample_ref(A, L);
            att::fox_prime<float, true>(cur, (char*)lds_raw + RING_OFF, S);
            att::fox_block<float, true>(cur, cur, (char*)lds_raw + RING_OFF, S);
            VM_WAIT(); __syncthreads();
          } }
#endif
        if (BOTH(2)) GRID_BAR();
    }

    if (IN(3)) { KArgs A = launder_kernarg(); unsigned char* ws = A->ws; (void)ws; THREAD_IDS();
        { const int rpb = (MT + G - 1) / G; const int row = bid * rpb + tid;
          if (tid < rpb && row < MT) { const f32x4* p = (const f32x4*)((const float*)(ws + WS_ESS) + (size_t)row * 32); float ss = 0.f;
#pragma unroll
              for (int j = 0; j < 8; ++j) { const f32x4 v = p[j]; ss += (v[0] + v[1]) + (v[2] + v[3]); }
              ((float*)(ws + WS_RSTDE))[row] = 1.0f / sqrtf(ss * (1.0f / DM) + EPS); } }
        { pg8::Gemm g{DSSM, DSSM, DSSM}; pg8::StaticOrder S; S.init((const bf16*)(ws + WS_YACT), (const bf16*)(ws + WS_WGLU_T), DSSM, DSSM, MT, DSSM, G, bid);
          EpiGlu E{(const bf16*)(ws + WS_YACT), (const bf16*)(ws + WS_SGS), (bf16*)(ws + WS_MIXED)};
          pg8::gemm_phase<EpiGlu, pg8::StaticOrder, true, true>(lds + RING_OFF, g, S, E); }
        if (BOTH(3)) GRID_BAR();
    }

    if (IN(4)) { KArgs A = launder_kernarg(); unsigned char* ws = A->ws; (void)ws;
        { pg8::Gemm g{DM, DM, DM}; pg8::StaticOrder S; S.init((const bf16*)(ws + WS_MIXED), (const bf16*)(ws + WS_WOUT_T), DM, DM, MT, DM, G, bid);
          EpiOut E{A->in[I_XP], A->in[I_XS], A->out + O_YP, A->out + O_YS, (bf16*)(ws + WS_HB)};
          pg8::gemm_phase<EpiOut, pg8::StaticOrder, true, true>(lds + RING_OFF, g, S, E); }
        if (BOTH(4)) GRID_BAR();
    }

    if (IN(5)) { KArgs A = launder_kernarg(); unsigned char* ws = A->ws; (void)ws;
        { pg8::Gemm g{DM, DM, DM}; pg8::StaticOrder S; S.init((const bf16*)(ws + WS_HB), (const bf16*)(ws + WS_WPG_T), DM, DM, MT, DM, G, bid);
          EpiPg E{A->out + O_YP, A->out + O_YS, (const bf16*)(ws + WS_E), (const float*)(ws + WS_RSTDE), A->in[I_GPE], (float*)(ws + WS_H2SS)};
          pg8::gemm_phase<EpiPg, pg8::StaticOrder, true, true>(lds + RING_OFF, g, S, E); }
        if (BOTH(5)) GRID_BAR();
    }

    if (IN(6)) { KArgs A = launder_kernarg(); unsigned char* ws = A->ws; (void)ws; THREAD_IDS();
        const int gw = bid * NWAVES + wave, NGW = G * NWAVES;
        f32x4 gf[8];
#pragma unroll
        for (int j = 0; j < 8; ++j) gf[j] = *(const f32x4*)(A->in[I_GFIN] + 256 * j + 4 * lane);
        for (int row = gw; row < MT; row += NGW) {
            float ss = lane < 32 ? ((const float*)(ws + WS_H2SS))[(size_t)row * 32 + lane] : 0.f;
            const float rstd = 1.0f / sqrtf(wave_sum(ss) * (1.0f / DM) + EPS);
            float* yr = row < MP ? A->out + O_YP + (size_t)row * DM : A->out + O_YS + (size_t)(row - MP) * DM;
#pragma unroll
            for (int j = 0; j < 8; ++j) { f32x4 v = *(const f32x4*)(yr + 256 * j + 4 * lane); v = v * rstd * gf[j]; *(f32x4*)(yr + 256 * j + 4 * lane) = v; }
        }
    }
#undef IN
#undef BOTH
}
constexpr int NPHASE = 7;

extern "C" void kernel_launch(void* const* d_in, const int* in_sizes, int n_in, void* d_out, int out_size, void* d_ws, size_t ws_size, hipStream_t stream) {
    static int grid = 0;
    if (grid == 0) {
        if (n_in != N_IN || in_sizes[0] != MP * DM || (size_t)out_size != O_END || ws_size < WS_END) {
            fprintf(stderr, "kernel_launch: unexpected shapes (n_in %d, in0 %d, out %d, ws %zu); nothing launched\n", n_in, n_in > 0 ? in_sizes[0] : -1, out_size, ws_size); grid = -1; return; }
        int dev = 0, cus = 0, per_cu = 0;
        if (hipGetDevice(&dev) != hipSuccess || hipDeviceGetAttribute(&cus, hipDeviceAttributeMultiprocessorCount, dev) != hipSuccess) { grid = -1; return; }
        if (hipFuncSetAttribute((const void*)fox_s5_fwd, hipFuncAttributeMaxDynamicSharedMemorySize, LDS_BYTES) != hipSuccess) { fprintf(stderr, "kernel_launch: hipFuncSetAttribute failed\n"); grid = -1; return; }
        if (hipOccupancyMaxActiveBlocksPerMultiprocessor(&per_cu, (const void*)fox_s5_fwd, NTHR, LDS_BYTES) != hipSuccess || per_cu < 1)
            fprintf(stderr, "kernel_launch: note: occupancy query reports %d workgroups per CU\n", per_cu);
        (void)hipGetLastError();
        grid = cus;
    }
    if (grid < 0) return;
    (void)hipMemsetAsync((char*)d_ws + WS_CTL, 0, CTL_ZERO_BYTES, stream);
    Args a{};
    for (int i = 0; i < N_IN; ++i) a.in[i] = (const float*)d_in[i];
    a.out = (float*)d_out; a.ws = (unsigned char*)d_ws;
#if MK_ONE_LAUNCH
    a.ph_lo = 0; a.ph_hi = NPHASE;
    hipLaunchKernelGGL(fox_s5_fwd, dim3(grid), dim3(NTHR), LDS_BYTES, stream, a);
#else
    for (int ph = 0; ph < NPHASE; ++ph) { a.ph_lo = ph; a.ph_hi = ph + 1; hipLaunchKernelGGL(fox_s5_fwd, dim3(grid), dim3(NTHR), LDS_BYTES, stream, a); }
#endif
}
```

```cpp
#include <hip/hip_runtime.h>
#include <cstdio>
#include <cstdint>

#ifndef MK_ONE_LAUNCH
#define MK_ONE_LAUNCH 1
#endif
#ifndef DBG_GP
#define DBG_GP 0
#endif

namespace pg8 {
#define PG8_LAS __attribute__((address_space(3)))
typedef unsigned short bf16_t;
typedef short bf16x8 __attribute__((ext_vector_type(8)));
typedef float f32x4 __attribute__((ext_vector_type(4)));
typedef unsigned u32x4 __attribute__((ext_vector_type(4)));
constexpr int BM = 256, BK = 64, HALF = 128, HTB = HALF * BK * 2  , STAGE_BYTES = 8 * HTB, NXCD = 8, WGM = 8;

__host__ __device__ __forceinline__ int lds_byte(int r, int c) { const int st = (r >> 4) * 2 + (c >> 5), rr = r & 15, cc = c & 31, ob = rr * 64 + cc * 2; return st * 1024 + (ob ^ (((ob >> 9) & 1) << 5)); }
__host__ __device__ __forceinline__ void stage_rc(int b, int& R, int& C) { const int st = b / 1024, sb = b % 1024, swz = sb ^ (((sb >> 9) & 1) << 5); R = (st >> 1) * 16 + swz / 64; C = (st & 1) * 32 + (swz % 64) / 2; }
__host__ __device__ __forceinline__ int perm32(int rho) { const int n = rho >> 4, i = rho & 15; return 8 * (i >> 2) + 4 * n + (i & 3); }

struct Unit { int pm, pn, g; };
struct Gemm { int lda, ldb, K; };

struct StaticOrder {
    const bf16_t* A; const bf16_t* Bt; size_t ta, tb;
    int nM, nN, nwg, G, c;
    __device__ void init(const bf16_t* A_, const bf16_t* Bt_, int lda, int ldb, int M, int N, int G_, int c_) { A = A_; Bt = Bt_; ta = (size_t)BM * lda * 2; tb = (size_t)BM * ldb * 2; nM = M / BM; nN = N / BM; nwg = nM * nN; G = G_; c = c_; }
    __device__ bool next(int i, Unit& u) const {
        const long L = (long)i * G + c; if (L >= nwg) return false;
        int wgid = (int)L; { const int q = nwg / NXCD, r = nwg % NXCD, xcd = wgid % NXCD, off = wgid / NXCD; wgid = (xcd < r ? xcd * (q + 1) : r * (q + 1) + (xcd - r) * q) + off; }
        const int nig = WGM * nN, gid = wgid / nig, fm = gid * WGM, gsz = (nM - fm) < WGM ? (nM - fm) : WGM;
        u.pm = fm + ((wgid % nig) % gsz); u.pn = (wgid % nig) / gsz; u.g = 0; return true;
    }
    __device__ __forceinline__ const char* a_ptr(const Unit& u) const { return (const char*)A + (size_t)u.pm * ta; }
    __device__ __forceinline__ const char* b_ptr(const Unit& u) const { return (const char*)Bt + (size_t)u.pn * tb; }
    __device__ __forceinline__ void a_ready(const Unit&) const {}
    __device__ __forceinline__ void done(const Unit&) const {}
};

__device__ __forceinline__ unsigned cvt_pk_bf16(float lo, float hi) { unsigned r; asm volatile("v_cvt_pk_bf16_f32 %0, %1, %2" : "=v"(r) : "v"(lo), "v"(hi)); return r; }
__device__ __forceinline__ float bf_lo(unsigned w) { return __uint_as_float(w << 16); }
__device__ __forceinline__ float bf_hi(unsigned w) { return __uint_as_float(w & 0xffff0000u); }
__device__ __forceinline__ float sigmoidf_(float x) { return __builtin_amdgcn_rcpf(1.0f + __builtin_amdgcn_exp2f(-1.4426950408889634f * x)); }
__device__ __forceinline__ float siluf_(float x) { return x * sigmoidf_(x); }
__device__ __forceinline__ float gelu_tanh_(float x) { const float t = 0.7978845608028654f * (x + 0.044715f * x * x * x); return x * sigmoidf_(2.0f * t); }
__device__ __forceinline__ u32x4 pack8f(const f32x4& a, const f32x4& b) { u32x4 w; w.x = cvt_pk_bf16(a[0], a[1]); w.y = cvt_pk_bf16(a[2], a[3]); w.z = cvt_pk_bf16(b[0], b[1]); w.w = cvt_pk_bf16(b[2], b[3]); return w; }

template <class Epi, class Sched, bool ALIGN_EPI = false, bool SP2 = false>
__device__ __forceinline__ void gemm_phase(PG8_LAS unsigned char* lds, const Gemm g, const Sched& S, const Epi& E) {
    const int tid = threadIdx.x, wid = __builtin_amdgcn_readfirstlane(tid >> 6), lane = tid & 63, wr = wid >> 2, wc = wid & 3, fr = lane & 15, fq = lane >> 4;
    const int K = g.K, nt = K / BK;
    unsigned voffA[2], voffB[2];
#pragma unroll
    for (int i = 0; i < 2; ++i) { int R, C; stage_rc(tid * 16 + i * 8192, R, C); const int Rb = Epi::PERM ? ((R & ~31) + perm32(R & 31)) : R;
        voffA[i] = (unsigned)(R * g.lda + C) * 2u; voffB[i] = (unsigned)(Rb * g.ldb + C) * 2u; }
    const size_t kstep = (size_t)(BK * 2);
    const size_t hstepA = (size_t)HALF * g.lda * 2, hstepB = (size_t)HALF * g.ldb * 2;
    const unsigned ldsw = (unsigned)wid * 1024u;
    const int aoff = lds_byte(wr * 64 + fr, fq * 8), boff = lds_byte(wc * 32 + fr, fq * 8);
#define PG8_SA(b, h) (((b) * 2 + (h)) * HTB)
#define PG8_SB(b, h) ((4 + (b) * 2 + (h)) * HTB)
#define PG8_STAGE(bufoff, gbase, voff) do { _Pragma("unroll") for (int _i = 0; _i < 2; ++_i) \
        __builtin_amdgcn_global_load_lds((const unsigned*)((const char*)(gbase) + (voff)[_i]), (PG8_LAS unsigned*)(lds + (bufoff) + ldsw + _i * 8192), 16, 0, 0); } while (0)
#define PG8_LDA(dst, b, h) do { _Pragma("unroll") for (int m = 0; m < 4; ++m) _Pragma("unroll") for (int k = 0; k < 2; ++k) dst[m][k] = *(const PG8_LAS bf16x8*)(lds + PG8_SA(b, h) + aoff + m * 2048 + k * 1024); } while (0)
#define PG8_LDB(dst, b, h) do { _Pragma("unroll") for (int n = 0; n < 2; ++n) _Pragma("unroll") for (int k = 0; k < 2; ++k) dst[n][k] = *(const PG8_LAS bf16x8*)(lds + PG8_SB(b, h) + boff + n * 2048 + k * 1024); } while (0)
#define PG8_MMA(ai, bj, At, Bt) do { __builtin_amdgcn_s_setprio(1); _Pragma("unroll") for (int m = 0; m < 4; ++m) _Pragma("unroll") for (int n = 0; n < 2; ++n) _Pragma("unroll") for (int k = 0; k < 2; ++k) \
        acc[ai][bj][m][n] = __builtin_amdgcn_mfma_f32_16x16x32_bf16(Bt[n][k], At[m][k], acc[ai][bj][m][n], 0, 0, 0); __builtin_amdgcn_s_setprio(0); } while (0)
#define PG8_WAIT_V(n) asm volatile("s_waitcnt vmcnt(" #n ")" ::: "memory")
#define PG8_WAIT_L(n) asm volatile("s_waitcnt lgkmcnt(" #n ")" ::: "memory")
#define PG8_BAR __builtin_amdgcn_s_barrier()
#define PG8_SCHED __builtin_amdgcn_sched_barrier(0)
    Unit cur, nxt; int ui = 0;
    if (!S.next(0, cur)) return;
    f32x4 acc[2][2][4][2];
#pragma unroll
    for (int a = 0; a < 2; ++a)
#pragma unroll
        for (int b = 0; b < 2; ++b)
#pragma unroll
            for (int m = 0; m < 4; ++m)
#pragma unroll
                for (int n = 0; n < 2; ++n) acc[a][b][m][n] = (f32x4){0.f, 0.f, 0.f, 0.f};
    bf16x8 At[4][2], B0[2][2], B1[2][2];
    const char* cA = S.a_ptr(cur); const char* cB = S.b_ptr(cur);
    S.a_ready(cur);
    if constexpr (SP2) {
        PG8_STAGE(PG8_SB(0, 0), cB, voffB); PG8_STAGE(PG8_SB(0, 1), cB + hstepB, voffB); PG8_STAGE(PG8_SA(0, 0), cA, voffA); PG8_STAGE(PG8_SA(0, 1), cA + hstepA, voffA);
        if (wr == 1) PG8_BAR;
        PG8_WAIT_V(2); PG8_BAR;
        PG8_STAGE(PG8_SB(1, 0), cB + kstep, voffB); PG8_STAGE(PG8_SA(1, 0), cA + kstep, voffA); PG8_STAGE(PG8_SB(1, 1), cB + hstepB + kstep, voffB);
        PG8_WAIT_V(6); PG8_BAR;
    } else {
        PG8_STAGE(PG8_SB(0, 0), cB, voffB); PG8_STAGE(PG8_SA(0, 0), cA, voffA); PG8_STAGE(PG8_SB(0, 1), cB + hstepB, voffB); PG8_STAGE(PG8_SA(0, 1), cA + hstepA, voffA);
        if (wr == 1) PG8_BAR;
        PG8_WAIT_V(4); PG8_BAR;
        PG8_STAGE(PG8_SB(1, 0), cB + kstep, voffB); PG8_STAGE(PG8_SA(1, 0), cA + kstep, voffA); PG8_STAGE(PG8_SB(1, 1), cB + hstepB + kstep, voffB);
        PG8_WAIT_V(6); PG8_BAR;
    }
    for (;;) {
        const bool has_next = S.next(ui + 1, nxt);
        const char* nA = has_next ? S.a_ptr(nxt) : cA; const char* nB = has_next ? S.b_ptr(nxt) : cB;
        for (int t = 0; t < nt; t += 2) {
            const bool last = (t == nt - 2);
            const char* a1 = cA + (size_t)(t + 1) * kstep;
            const char* a2 = last ? nA : cA + (size_t)(t + 2) * kstep; const char* b2 = last ? nB : cB + (size_t)(t + 2) * kstep;
            const char* a3 = a2 + kstep; const char* b3 = b2 + kstep;
            if (last && has_next) S.a_ready(nxt);
            if constexpr (SP2) {
            PG8_LDB(B0, 0, 0); PG8_LDB(B1, 0, 1); PG8_SCHED; PG8_LDA(At, 0, 0); PG8_STAGE(PG8_SA(1, 1), a1 + hstepA, voffA);
            PG8_WAIT_V(8); PG8_WAIT_L(0); PG8_BAR; PG8_MMA(0, 0, At, B0); PG8_MMA(0, 1, At, B1); PG8_BAR; PG8_SCHED;
            PG8_LDA(At, 0, 1); PG8_STAGE(PG8_SB(0, 0), b2, voffB); PG8_STAGE(PG8_SB(0, 1), b2 + hstepB, voffB); PG8_STAGE(PG8_SA(0, 0), a2, voffA);
            PG8_WAIT_V(8); PG8_WAIT_L(0); PG8_BAR; PG8_MMA(1, 0, At, B0); PG8_MMA(1, 1, At, B1); PG8_BAR; PG8_SCHED;
            PG8_LDB(B0, 1, 0); PG8_LDB(B1, 1, 1); PG8_SCHED; PG8_LDA(At, 1, 0); PG8_STAGE(PG8_SA(0, 1), a2 + hstepA, voffA);
            PG8_WAIT_V(8); PG8_WAIT_L(0); PG8_BAR; PG8_MMA(0, 0, At, B0); PG8_MMA(0, 1, At, B1); PG8_BAR; PG8_SCHED;
            PG8_LDA(At, 1, 1); PG8_STAGE(PG8_SB(1, 0), b3, voffB); PG8_STAGE(PG8_SB(1, 1), b3 + hstepB, voffB); PG8_STAGE(PG8_SA(1, 0), a3, voffA);
            PG8_WAIT_V(8); PG8_WAIT_L(0); PG8_BAR; PG8_MMA(1, 0, At, B0); PG8_MMA(1, 1, At, B1); PG8_BAR; PG8_SCHED;
            } else {
            PG8_LDB(B0, 0, 0); PG8_SCHED; PG8_LDA(At, 0, 0); PG8_STAGE(PG8_SA(1, 1), a1 + hstepA, voffA);
            PG8_WAIT_L(8); PG8_BAR; PG8_WAIT_L(0); PG8_MMA(0, 0, At, B0); PG8_BAR; PG8_SCHED;
            PG8_LDB(B1, 0, 1); PG8_STAGE(PG8_SB(0, 0), b2, voffB);
            PG8_BAR; PG8_WAIT_L(0); PG8_MMA(0, 1, At, B1); PG8_BAR;
            PG8_LDA(At, 0, 1); PG8_STAGE(PG8_SA(0, 0), a2, voffA);
            PG8_BAR; PG8_WAIT_L(0); PG8_MMA(1, 0, At, B0); PG8_BAR; PG8_SCHED;
            PG8_STAGE(PG8_SB(0, 1), b2 + hstepB, voffB);
            PG8_WAIT_V(6); PG8_BAR; PG8_MMA(1, 1, At, B1); PG8_BAR;
            PG8_LDB(B0, 1, 0); PG8_SCHED; PG8_LDA(At, 1, 0); PG8_STAGE(PG8_SA(0, 1), a2 + hstepA, voffA);
            PG8_WAIT_L(8); PG8_BAR; PG8_WAIT_L(0); PG8_MMA(0, 0, At, B0); PG8_BAR; PG8_SCHED;
            PG8_LDB(B1, 1, 1); PG8_STAGE(PG8_SB(1, 0), b3, voffB);
            PG8_BAR; PG8_WAIT_L(0); PG8_MMA(0, 1, At, B1); PG8_BAR;
            PG8_LDA(At, 1, 1); PG8_STAGE(PG8_SA(1, 0), a3, voffA);
            PG8_BAR; PG8_WAIT_L(0); PG8_MMA(1, 0, At, B0); PG8_BAR; PG8_SCHED;
            PG8_STAGE(PG8_SB(1, 1), b3 + hstepB, voffB);
            PG8_WAIT_V(6); PG8_BAR; PG8_MMA(1, 1, At, B1); PG8_BAR;
            }
        }
        if constexpr (ALIGN_EPI) { if (wr == 0) PG8_BAR; }
        if constexpr (!Epi::AFTER_DRAIN) { E(acc, cur, wr, wc, fr, fq); S.done(cur); }
        if (!has_next) break;
#pragma unroll
        for (int a = 0; a < 2; ++a)
#pragma unroll
            for (int b = 0; b < 2; ++b)
#pragma unroll
                for (int m = 0; m < 4; ++m)
#pragma unroll
                    for (int n = 0; n < 2; ++n) acc[a][b][m][n] = (f32x4){0.f, 0.f, 0.f, 0.f};
        cur = nxt; cA = nA; cB = nB; ++ui;
        if constexpr (ALIGN_EPI) { if (wr == 1) PG8_BAR; }
    }
    PG8_WAIT_V(0);
    if constexpr (!ALIGN_EPI) { if (wr == 0) PG8_BAR; }
    PG8_BAR;
    if constexpr (Epi::AFTER_DRAIN) { E.fused(acc, cur, wr, wc, fr, fq, lds, wid, lane); S.done(cur); }
#undef PG8_SA
#undef PG8_SB
#undef PG8_STAGE
#undef PG8_LDA
#undef PG8_LDB
#undef PG8_MMA
#undef PG8_WAIT_V
#undef PG8_WAIT_L
#undef PG8_BAR
#undef PG8_SCHED
}
}

namespace att {
typedef unsigned short bf16;
typedef short bf16x8 __attribute__((ext_vector_type(8)));
typedef short s16x4 __attribute__((ext_vector_type(4)));
typedef float f32x16 __attribute__((ext_vector_type(16)));
typedef float f32x4 __attribute__((ext_vector_type(4)));
typedef unsigned u32x4 __attribute__((ext_vector_type(4)));
constexpr int D = 128, NW = 8, QBLK = 32, KVBLK = 64, QB = NW * QBLK;
constexpr int QP = 1024, KP = 1024, OP = 2048, GPI = 1024;
constexpr int SHM_V = KVBLK * D * 2, SHM_K = KVBLK * D * 2;
constexpr int LDS_BYTES = 2 * SHM_V + 2 * SHM_K + NW * 64 * 4;
constexpr float SCALE = 0.08838834764831845f, THR = 8.f;
template <class A, class Bt> struct same_t { static constexpr bool v = false; };
template <class A> struct same_t<A, A> { static constexpr bool v = true; };

#define KSWZ(row, colB) ((row) * 256 + ((colB) ^ (((row) & 7) << 4)))
#define SBAR() __builtin_amdgcn_sched_barrier(0)
__device__ __forceinline__ int v_st(int k, int c) { const int kk = (k & ~0xC) | ((k & 4) << 1) | ((k & 8) >> 1); return ((kk >> 3) * 4 + (c >> 5)) * 512 + ((kk & 7) * 32 + (c & 31)) * 2; }
__device__ __forceinline__ int v_rd_base(int lane) { return ((lane & 3) << 3) | (((lane >> 2) & 3) << 6) | (((lane >> 4) & 1) << 5) | (((lane >> 5) & 1) << 8); }
constexpr int v_rd_off(int d0, int ks, int half) { return d0 * 512 + ks * 4096 + half * 2048; }
__device__ __forceinline__ int crow(int r, int hi) { return (r & 3) + 8 * (r >> 2) + 4 * hi; }
__device__ __forceinline__ unsigned cvtpk(float lo, float hi) { unsigned r; asm volatile("v_cvt_pk_bf16_f32 %0, %1, %2" : "=v"(r) : "v"(lo), "v"(hi)); return r; }
__device__ __forceinline__ bf16x8 pack8(f32x4 a, f32x4 b) { u32x4 w = {cvtpk(a[0], a[1]), cvtpk(a[2], a[3]), cvtpk(b[0], b[1]), cvtpk(b[2], b[3])}; return *reinterpret_cast<bf16x8*>(&w); }
__device__ __forceinline__ bf16x8 ld8h(const bf16* p) { return *reinterpret_cast<const bf16x8*>(p); }

__device__ __forceinline__ void mask_tile(f32x16& p0, f32x16& p1, int dq) {
    const float NEG = -__builtin_inff();
#pragma unroll
    for (int r = 0; r < 16; ++r) {
        const int c = (r & 3) + 8 * (r >> 2);
        if (dq - c < 0) p0[r] = NEG;
        if (dq - c - 32 < 0) p1[r] = NEG;
    }
}
__device__ __forceinline__ void partialSM(f32x16& p0, f32x16& p1, float& m_reg, float& mn, float& alpha) {
    float pmax = p0[0]; for (int r = 1; r < 16; ++r) pmax = fmaxf(pmax, p0[r]); for (int r = 0; r < 16; ++r) pmax = fmaxf(pmax, p1[r]);
    { auto rr = __builtin_amdgcn_permlane32_swap(__float_as_uint(pmax), __float_as_uint(pmax), false, false);
      pmax = fmaxf(__uint_as_float(rr[0]), __uint_as_float(rr[1])); }
    constexpr float C2 = 1.4426950408889634f * SCALE;
    if (__builtin_expect(__all((pmax - m_reg) * SCALE <= THR), 1)) { mn = m_reg; alpha = 1.f; }
    else { mn = fmaxf(m_reg, pmax); alpha = __builtin_amdgcn_exp2f((m_reg - mn) * C2); m_reg = mn; }
    const float mnL = -mn * C2;
    for (int r = 0; r < 16; ++r) p0[r] = fmaf(p0[r], C2, mnL); for (int r = 0; r < 16; ++r) p1[r] = fmaf(p1[r], C2, mnL);
    for (int r = 0; r < 16; ++r) p0[r] = __builtin_amdgcn_exp2f(p0[r]);
}
__device__ __forceinline__ void finishSM(f32x16& p0, f32x16& p1, float alpha, float& l_reg, bf16x8& pa0, bf16x8& pa1, bf16x8& pa2, bf16x8& pa3) {
    for (int r = 0; r < 16; ++r) p1[r] = __builtin_amdgcn_exp2f(p1[r]);
    float ps = 0; for (int r = 0; r < 16; ++r) ps += p0[r]; for (int r = 0; r < 16; ++r) ps += p1[r];
    { auto rr = __builtin_amdgcn_permlane32_swap(__float_as_uint(ps), __float_as_uint(ps), false, false);
      ps = __uint_as_float(rr[0]) + __uint_as_float(rr[1]); }
    l_reg = l_reg * alpha + ps;
#define PK4(P, B_, OUT) do { unsigned a0 = cvtpk(P[B_+0], P[B_+1]), a1 = cvtpk(P[B_+2], P[B_+3]);                          \
        unsigned b0 = cvtpk(P[B_+4], P[B_+5]), b1 = cvtpk(P[B_+6], P[B_+7]);                                             \
        auto r0 = __builtin_amdgcn_permlane32_swap(a0, b0, false, false); auto r1 = __builtin_amdgcn_permlane32_swap(a1, b1, false, false); \
        u32x4 w = {r0[0], r1[0], r0[1], r1[1]}; OUT = *reinterpret_cast<bf16x8*>(&w); } while (0)
    PK4(p0, 0, pa0); PK4(p0, 8, pa1); PK4(p1, 0, pa2); PK4(p1, 8, pa3);
#undef PK4
}
__device__ __forceinline__ void loadck(f32x16& p0, f32x16& p1, const float* CK, int off  ) { const float* ckt = CK + off;
#pragma unroll
    for (int g = 0; g < 4; ++g) { const f32x4 a = *(const f32x4*)(ckt + 8 * g), b = *(const f32x4*)(ckt + 32 + 8 * g);
        p0[4 * g] = a[0]; p0[4 * g + 1] = a[1]; p0[4 * g + 2] = a[2]; p0[4 * g + 3] = a[3];
        p1[4 * g] = b[0]; p1[4 * g + 1] = b[1]; p1[4 * g + 2] = b[2]; p1[4 * g + 3] = b[3]; }
}
template <int KB, bool SK>
__device__ __forceinline__ void qkt(f32x16& p0, f32x16& p1, const char* K_lds, int r32, int hi, const bf16x8* qr, float cqv, bool act) {
    if (SK && !act) { const float NEG = -__builtin_inff();
#pragma unroll
        for (int r = 0; r < 16; ++r) { p0[r] = NEG; p1[r] = NEG; } return; }
#pragma unroll
    for (int r = 0; r < 16; ++r) { p0[r] = cqv - p0[r]; p1[r] = cqv - p1[r]; }
    const char* kb[4];
#pragma unroll
    for (int dd = 0; dd < 4; ++dd) kb[dd] = K_lds + KB * SHM_K + KSWZ(r32, (dd * 16 + hi * 8) * 2);
#pragma unroll
    for (int d0 = 0; d0 < 8; ++d0) { const char* a = kb[d0 & 3] + (d0 >> 2) * 128;
        bf16x8 b0 = *reinterpret_cast<const bf16x8*>(a);
        bf16x8 b1 = *reinterpret_cast<const bf16x8*>(a + 32 * 256);
        p0 = __builtin_amdgcn_mfma_f32_32x32x16_bf16(b0, qr[d0], p0, 0, 0, 0);
        p1 = __builtin_amdgcn_mfma_f32_32x32x16_bf16(b1, qr[d0], p1, 0, 0, 0);
        if (d0 == 3) SBAR(); }
}
template <int VB, int ND>
__device__ __forceinline__ void pv_tile(f32x16* o, int vb0, bf16x8 pa0, bf16x8 pa1, bf16x8 pa2, bf16x8 pa3) {
#define TRRD(dst, off) asm volatile("ds_read_b64_tr_b16 %0, %1 offset:%2" : "=&v"(dst) : "v"(vb0), "i"(off) : "memory")
#define PV_D0(d0) do { s16x4 l0, l1, l2, l3, h0, h1, h2, h3; constexpr int b_ = VB * SHM_V + v_rd_off(d0, 0, 0); \
        TRRD(l0, b_); TRRD(h0, b_ + 2048); TRRD(l1, b_ + 4096); TRRD(h1, b_ + 6144); TRRD(l2, b_ + 8192); TRRD(h2, b_ + 10240); TRRD(l3, b_ + 12288); TRRD(h3, b_ + 14336); \
        asm volatile("s_waitcnt lgkmcnt(0)" ::: "memory"); SBAR();   \
        o[d0] = __builtin_amdgcn_mfma_f32_32x32x16_bf16((bf16x8){l0[0], l0[1], l0[2], l0[3], h0[0], h0[1], h0[2], h0[3]}, pa0, o[d0], 0, 0, 0);   \
        o[d0] = __builtin_amdgcn_mfma_f32_32x32x16_bf16((bf16x8){l1[0], l1[1], l1[2], l1[3], h1[0], h1[1], h1[2], h1[3]}, pa1, o[d0], 0, 0, 0);   \
        o[d0] = __builtin_amdgcn_mfma_f32_32x32x16_bf16((bf16x8){l2[0], l2[1], l2[2], l2[3], h2[0], h2[1], h2[2], h2[3]}, pa2, o[d0], 0, 0, 0);   \
        o[d0] = __builtin_amdgcn_mfma_f32_32x32x16_bf16((bf16x8){l3[0], l3[1], l3[2], l3[3], h3[0], h3[1], h3[2], h3[3]}, pa3, o[d0], 0, 0, 0); } while (0)
    PV_D0(0); if constexpr (ND == 4) { PV_D0(1); PV_D0(2); PV_D0(3); }
#undef PV_D0
#undef TRRD
}

template <class TKV> struct BlockRef { const bf16* Q; const TKV* K; const TKV* V; const TKV* Kn; const TKV* Vn; bf16* O; const bf16* G; const float* CQ; const float* CK; int np, P0, jhi; };
struct Seam { bf16x8 qr[8]; bf16x8 st_v0, st_v1, st_k0, st_k1; f32x4 sf0, sf1, sf2, sf3; };

#define TBASE(ref, base, basen, k0, half) ((F32 && (k0) >= (ref).np) ? (const char*)(basen) : (const char*)((base) + (size_t)((k0) + 32 * (half)) * KP))
#define VMW() asm volatile("s_waitcnt vmcnt(0)" ::: "memory")
#define VMWN(n) asm volatile("s_waitcnt vmcnt(%0)" :: "i"(n) : "memory")
#define SLOAD_H(ref, k0) do { S.st_v0 = *(const bf16x8*)(TBASE(ref, (ref).V, (ref).Vn, k0, 0) + rofs); S.st_v1 = *(const bf16x8*)(TBASE(ref, (ref).V, (ref).Vn, k0, 1) + rofs);              \
                              S.st_k0 = *(const bf16x8*)(TBASE(ref, (ref).K, (ref).Kn, k0, 0) + rofs); S.st_k1 = *(const bf16x8*)(TBASE(ref, (ref).K, (ref).Kn, k0, 1) + rofs); } while (0)
#define SWRITE_HK(bf) do { *(bf16x8*)(K_lds + (bf) * SHM_K + kws) = S.st_k0; *(bf16x8*)(K_lds + (bf) * SHM_K + kws + 32 * 256) = S.st_k1; } while (0)
#define SWRITE_HV(bf) do { *(bf16x8*)(V_lds + (bf) * SHM_V + vst0) = S.st_v0; *(bf16x8*)(V_lds + (bf) * SHM_V + vst0 + 8192) = S.st_v1; } while (0)
#define SWRITE_H(bf) do { SWRITE_HV(bf); SWRITE_HK(bf); } while (0)
#define SLOAD_FK(ref, k0) do { const char* r0_ = TBASE(ref, (ref).K, (ref).Kn, k0, 0) + rofs; const char* r1_ = TBASE(ref, (ref).K, (ref).Kn, k0, 1) + rofs; \
                               S.sf0 = *(const f32x4*)r0_; S.sf1 = *(const f32x4*)(r0_ + 16); S.sf2 = *(const f32x4*)r1_; S.sf3 = *(const f32x4*)(r1_ + 16); } while (0)
#define SLOAD_FV(ref, k0) do { const char* r0_ = TBASE(ref, (ref).V, (ref).Vn, k0, 0) + rofs; const char* r1_ = TBASE(ref, (ref).V, (ref).Vn, k0, 1) + rofs; \
                               S.sf0 = *(const f32x4*)r0_; S.sf1 = *(const f32x4*)(r0_ + 16); S.sf2 = *(const f32x4*)r1_; S.sf3 = *(const f32x4*)(r1_ + 16); } while (0)
#define SWRITE_KF(bf) do { *(bf16x8*)(K_lds + (bf) * SHM_K + kws) = pack8(S.sf0, S.sf1); *(bf16x8*)(K_lds + (bf) * SHM_K + kws + 32 * 256) = pack8(S.sf2, S.sf3); } while (0)
#define SWRITE_VF(bf) do { *(bf16x8*)(V_lds + (bf) * SHM_V + vst0) = pack8(S.sf0, S.sf1); *(bf16x8*)(V_lds + (bf) * SHM_V + vst0 + 8192) = pack8(S.sf2, S.sf3); } while (0)

template <class TKV, bool SOLO>
__device__ __forceinline__ void fox_prime(const BlockRef<TKV>& cur, char* lds, Seam& S) {
    constexpr bool F32 = same_t<TKV, float>::v;
    const int tid = threadIdx.x, wid = __builtin_amdgcn_readfirstlane(tid >> 6), lane = tid & 63, r32 = lane & 31, hi = lane >> 5;
    const int wq = SOLO ? 0 : wid;
    const int sr = tid >> 4, sc = (tid & 15) * 8, kws = KSWZ(sr, sc * 2); char* K_lds = lds + 2 * SHM_V;
    const unsigned rofs = (unsigned)(sr * KP + sc) * (unsigned)sizeof(TKV);
    constexpr int kb0 = 0;
#pragma unroll
    for (int d0 = 0; d0 < 8; ++d0) S.qr[d0] = ld8h(cur.Q + (size_t)(wq * QBLK + r32) * QP + d0 * 16 + hi * 8);
    if constexpr (F32) { SLOAD_FK(cur, kb0); VMW(); SWRITE_KF(0); SBAR(); SLOAD_FV(cur, kb0); }
    else { SLOAD_H(cur, kb0); VMW(); SWRITE_HK(0); }
    __syncthreads();
}
template <class TKV, bool SOLO>
__device__ __forceinline__ void fox_block(const BlockRef<TKV>& cur, const BlockRef<TKV>& nxt, char* lds, Seam& S) {
    constexpr bool F32 = same_t<TKV, float>::v;
    constexpr bool SK = false;
    const int tid = threadIdx.x, wid = __builtin_amdgcn_readfirstlane(tid >> 6), lane = tid & 63, r32 = lane & 31, hi = lane >> 5;
    const int wq = SOLO ? 0 : wid;
    constexpr bool wact = true;
    constexpr int j_lo = 0, kbn = 0;
    const int NT = cur.jhi;
    const int qlo = cur.P0 + wq * QBLK, qm = qlo + r32 - 4 * hi;
    char* V_lds = lds; char* K_lds = lds + 2 * SHM_V;
    constexpr int ND = SOLO ? 1 : 4;
    float m_reg = -1e30f, l_reg = 0; f32x16 o[ND] = {};
    const int sr = tid >> 4, sc = (tid & 15) * 8, vst0 = v_st(sr, sc), kws = KSWZ(sr, sc * 2);
    const unsigned rofs = (unsigned)(sr * KP + sc) * (unsigned)sizeof(TKV);
    const int vb0 = (int)(uintptr_t)V_lds + v_rd_base(lane) + (SOLO ? (wid & 3) * 512 : 0);
    const float cqv = cur.CQ[wq * QBLK + r32];
#define RESC(a) do { if (__any((a) < 1.f)) { for (int d_ = 0; d_ < ND; ++d_) for (int r = 0; r < 16; ++r) o[d_][r] *= (a); } } while (0)
#define KBASE(t) ((j_lo + (t)) * KVBLK)
#define MASKT(P0_, P1_, t) do { const int kb_ = KBASE(t); if (wact && kb_ + KVBLK - 1 > qlo) mask_tile(P0_, P1_, qm - kb_); } while (0)
#define LOADCK(P0_, P1_, t) do { if (wact) loadck(P0_, P1_, cur.CK, KBASE(t) + 4 * hi); } while (0)
    constexpr int NQL = 8;
#define SEAM_K0() do { VMWN(NQL); if constexpr (F32) { SWRITE_KF(0); SBAR(); SLOAD_FV(nxt, kbn); } else { SWRITE_HK(0); } SBAR(); } while (0)
    f32x16 pA0, pA1, pB0, pB1; float mnA, mnB, alA, alB; bf16x8 pa0, pa1, pa2, pa3;
    LOADCK(pA0, pA1, 0);
    if constexpr (F32) { VMW(); SWRITE_VF(0); SBAR(); } else { SWRITE_HV(0); SBAR(); }
    if (NT > 1) { if constexpr (F32) SLOAD_FK(cur, KBASE(1)); else SLOAD_H(cur, KBASE(1)); }
    SBAR(); qkt<0, SK>(pA0, pA1, K_lds, r32, hi, S.qr, cqv, wact);
    if (NT > 1) { LOADCK(pB0, pB1, 1); SBAR(); }
    if constexpr (F32) { if (NT > 1) { VMW(); SWRITE_KF(1); SBAR(); SLOAD_FV(cur, KBASE(1)); } }
    MASKT(pA0, pA1, 0); partialSM(pA0, pA1, m_reg, mnA, alA);
    if (NT > 1) { VMW(); if constexpr (F32) { SWRITE_VF(1); SBAR(); if (NT > 2) SLOAD_FK(cur, KBASE(2)); } else SWRITE_H(1); }
    __syncthreads();
#define HALF_STEP(PX0, PX1, mnX, alX, PY0, PY1, alY, t, KB, VB, SB) do {                                                      \
        SBAR(); qkt<KB, SK>(PX0, PX1, K_lds, r32, hi, S.qr, cqv, wact);                                                       \
        finishSM(PY0, PY1, alY, l_reg, pa0, pa1, pa2, pa3); SBAR();                                                           \
        if ((t) + 1 < NT) { if constexpr (F32) { VMW(); SWRITE_KF(SB); SBAR(); SLOAD_FV(cur, KBASE((t) + 1)); }               \
                            else { SLOAD_H(cur, KBASE((t) + 1)); } SBAR(); LOADCK(PY0, PY1, (t) + 1); SBAR(); }               \
        pv_tile<VB, ND>(o, vb0, pa0, pa1, pa2, pa3); MASKT(PX0, PX1, (t)); partialSM(PX0, PX1, m_reg, mnX, alX);        \
        __syncthreads();                                                                                                      \
        if ((t) + 1 < NT) { VMW(); if constexpr (F32) { SWRITE_VF(SB); SBAR(); if ((t) + 2 < NT) SLOAD_FK(cur, KBASE((t) + 2)); } \
                            else { SWRITE_H(SB); } }                                                                          \
        RESC(alX); __syncthreads(); } while (0)
    for (int t = 1; t + 1 < NT; t += 2) {
        HALF_STEP(pB0, pB1, mnB, alB, pA0, pA1, alA, t, 1, 0, 0);
        HALF_STEP(pA0, pA1, mnA, alA, pB0, pB1, alB, t + 1, 0, 1, 1);
    }
    const bool even = (NT & 1) == 0;
    if (even) { SBAR(); qkt<1, SK>(pB0, pB1, K_lds, r32, hi, S.qr, cqv, wact); SBAR(); }
    if constexpr (F32) { SLOAD_FK(nxt, kbn); SBAR(); } else { SLOAD_H(nxt, kbn); SBAR(); }
    { const int wqn = SOLO ? 0 : wid;
#pragma unroll
      for (int d0 = 0; d0 < 8; ++d0) S.qr[d0] = ld8h(nxt.Q + (size_t)(wqn * QBLK + r32) * QP + d0 * 16 + hi * 8); }
    SBAR();
    finishSM(pA0, pA1, alA, l_reg, pa0, pa1, pa2, pa3); SBAR();
    pv_tile<0, ND>(o, vb0, pa0, pa1, pa2, pa3);
    if (even) { MASKT(pB0, pB1, NT - 1); partialSM(pB0, pB1, m_reg, mnB, alB); __syncthreads(); RESC(alB);
        finishSM(pB0, pB1, alB, l_reg, pa0, pa1, pa2, pa3); SBAR(); pv_tile<1, ND>(o, vb0, pa0, pa1, pa2, pa3); }
    SBAR(); SEAM_K0();
    if (!SOLO || wid < 4) {
        const float inv = __builtin_amdgcn_rcpf(l_reg);
        const int cb = SOLO ? (wid & 3) * 32 : 0;
        bf16* Ow = cur.O + (size_t)(wq * QBLK + r32) * OP + 4 * hi + cb; const bf16* Gw = cur.G + (size_t)(wq * QBLK + r32) * GPI + 4 * hi + cb;
#pragma unroll
        for (int d0 = 0; d0 < ND; ++d0) {
#pragma unroll
            for (int g = 0; g < 4; ++g) { const uint2 gt = *(const uint2*)(Gw + d0 * 32 + 8 * g);
                uint2 w; w.x = cvtpk(o[d0][4 * g] * inv * __uint_as_float(gt.x << 16), o[d0][4 * g + 1] * inv * __uint_as_float(gt.x & 0xffff0000u));
                w.y = cvtpk(o[d0][4 * g + 2] * inv * __uint_as_float(gt.y << 16), o[d0][4 * g + 3] * inv * __uint_as_float(gt.y & 0xffff0000u));
                *(uint2*)(Ow + d0 * 32 + 8 * g) = w; }
            asm volatile("" ::: "memory"); }
    }
    __syncthreads();
#undef RESC
#undef KBASE
#undef MASKT
#undef LOADCK
#undef SEAM_K0
#undef HALF_STEP
}
#undef TBASE
#undef VMW
#undef VMWN
#undef SLOAD_H
#undef SWRITE_HK
#undef SWRITE_HV
#undef SWRITE_H
#undef SLOAD_FK
#undef SLOAD_FV
#undef SWRITE_KF
#undef SWRITE_VF
}

constexpr int DM = 2048, NB = 4, SEQ = 8192, DECB = 32, DECS = 32, PAST = 4096, NH = 8, HD = 128, DATT = 1024, DSSM = 1024, NG = 64, NST = 64, DPLE = 256;
constexpr int MP = NB * SEQ, MS = DECB * DECS, MT = MP + MS;
constexpr int DIN = 6152, OFF_F = 3072;
constexpr int NIN = 6144;
constexpr int CHUNK = 32, NCH = MT / CHUNK, UHROWS = NCH, UHLD = 640;
constexpr int NSSM_ITEMS = NG * 5;
constexpr int CSLD = 4160;
constexpr float EPS = 1e-6f;
constexpr size_t O_YP = 0, O_YS = O_YP + (size_t)MP * DM, O_KP = O_YS + (size_t)MS * DM, O_VP = O_KP + (size_t)MP * DATT, O_LFP = O_VP + (size_t)MP * DATT,
                 O_SRP = O_LFP + (size_t)MP * NH, O_SIP = O_SRP + NB * NG * NST, O_KS = O_SIP + NB * NG * NST, O_VS = O_KS + (size_t)MS * DATT, O_LFS = O_VS + (size_t)MS * DATT,
                 O_SRS = O_LFS + (size_t)MS * NH, O_SIS = O_SRS + DECB * NG * NST, O_END = O_SIS + DECB * NG * NST;
constexpr size_t MiB = 1u << 20;
constexpr size_t WS_CTL = 0, CTL_ZERO_BYTES = 1 * MiB;
constexpr size_t WS_WIN_T = 1 * MiB, WS_WGLU_T = 25 * MiB, WS_WOUT_T = 27 * MiB, WS_WPE_T = 35 * MiB, WS_WPG_T = 36 * MiB;
constexpr size_t WS_MW_T = 44 * MiB, WS_BP_T = 84 * MiB, WS_A32 = 100 * MiB, WS_LOGF = 101 * MiB, WS_CP = 103 * MiB, WS_CS = 104 * MiB;
constexpr size_t WS_ESS = 109 * MiB, WS_H2SS = 114 * MiB, WS_RSTDE = 119 * MiB;
constexpr size_t WS_XN = 120 * MiB, WS_PB = 252 * MiB, WS_Q = 270 * MiB, WS_K = 336 * MiB, WS_V = 402 * MiB, WS_SGA = 468 * MiB, WS_SGS = 534 * MiB;
constexpr size_t WS_UH = 600 * MiB, WS_SBUF = 684 * MiB, WS_YACT = 724 * MiB, WS_MIXED = 790 * MiB, WS_HB = 922 * MiB, WS_E = 1054 * MiB, WS_QSS = 1186 * MiB, WS_KSS = 1191 * MiB, WS_END = 1196 * MiB;
constexpr size_t WS_GP = 1200 * MiB;
static_assert(WS_LOGF + (size_t)MT * 8 * 4 <= WS_CP && WS_CS + (size_t)DECB * NH * CSLD * 4 <= WS_ESS && WS_ESS + (size_t)MT * 32 * 4 <= WS_H2SS && WS_H2SS + (size_t)MT * 32 * 4 <= WS_RSTDE, "ws map a");
static_assert(WS_XN + (size_t)MT * DM * 2 <= WS_PB && WS_PB + (size_t)MT * DPLE * 2 <= WS_Q && WS_Q + (size_t)MT * DATT * 2 <= WS_K && WS_UH + (size_t)(NG * UHROWS + 256) * UHLD * 2 <= WS_SBUF, "ws map b");
static_assert(WS_SBUF + (size_t)NSSM_ITEMS * 256 * 128 * 4 <= WS_YACT && WS_YACT + (size_t)MT * DSSM * 2 <= WS_MIXED && WS_MIXED + (size_t)MT * DM * 2 <= WS_HB && WS_E + (size_t)MT * DM * 2 <= WS_QSS && WS_QSS + (size_t)MT * 32 * 4 <= WS_KSS && WS_KSS + (size_t)MT * 32 * 4 <= WS_END, "ws map c");
constexpr int CW_TMO = 0, CW_BAR = 4096;

constexpr int NWAVES = 8, NTHR = 512;
constexpr int RING_OFF = 0, RING_BYTES = 131072, LDSCTL_OFF = RING_BYTES, MISC_OFF = LDSCTL_OFF + 320, LDS_BYTES = 147456;

#define GAS __attribute__((address_space(1)))
#define LAS __attribute__((address_space(3)))
typedef unsigned short bf16;
typedef unsigned v4u __attribute__((ext_vector_type(4)));
typedef unsigned v2u __attribute__((ext_vector_type(2)));
typedef float f32x4 __attribute__((ext_vector_type(4)));
typedef float f32x2 __attribute__((ext_vector_type(2)));
#define LDS_WAIT() asm volatile("s_waitcnt lgkmcnt(0)" ::: "memory")
#define VM_WAIT() asm volatile("s_waitcnt vmcnt(0)" ::: "memory")
__device__ __forceinline__ unsigned f2bf(float f) { unsigned u = __builtin_bit_cast(unsigned, f); return (u + 0x7fffu + ((u >> 16) & 1u)) >> 16; }
__device__ __forceinline__ unsigned pk2(float lo, float hi) { return f2bf(lo) | (f2bf(hi) << 16); }
__device__ __forceinline__ float wave_sum(float v) {
#pragma unroll
    for (int o = 1; o < 64; o <<= 1) v += __shfl_xor(v, o);
    return v;
}

#define XB_TMO      128
#define XB_XCNT(j)  (256  + 64 * (j))
#define XB_XSUB(j)  (1280 + 64 * (j))
#define XB_XGEN(j)  (2304 + 64 * (j))
#define XB_TOP      3328
#define XB_TOPGEN   3392
#define XCD_BAR_WORDS 3456
#define XB_SPIN_CAP (1u << 22)
__device__ __forceinline__ unsigned xb_ld(unsigned* p)              { return __hip_atomic_load(p, __ATOMIC_RELAXED, __HIP_MEMORY_SCOPE_AGENT); }
__device__ __forceinline__ unsigned xb_add(unsigned* p, unsigned v) { return __hip_atomic_fetch_add(p, v, __ATOMIC_RELAXED, __HIP_MEMORY_SCOPE_AGENT); }
__device__ __forceinline__ unsigned xb_xcc_id() { return (unsigned)__builtin_amdgcn_s_getreg((3 << 11) | 20) & 0xFu; }
#define XB_SPIN(cond, bar) do { unsigned _sp = 0; while (cond) { __builtin_amdgcn_s_sleep(1); \
    if ((++_sp & 255u) == 0u) { if (xb_ld(&(bar)[XB_TMO])) break; if (_sp > XB_SPIN_CAP) { atomicAdd(&(bar)[XB_TMO], 1u); break; } } } } while (0)
struct XcdBarrier { unsigned* bar; unsigned x; volatile LAS unsigned* st; };
__device__ __forceinline__ XcdBarrier xcd_barrier_post(unsigned* bar, volatile LAS unsigned* st) {
    XcdBarrier b; b.bar = bar; b.x = xb_xcc_id(); b.st = st;
    if (threadIdx.x == 0) (void)xb_add(&bar[XB_XCNT(b.x)], 1u);
    return b;
}
__device__ __forceinline__ void xcd_barrier_complete(unsigned* bar, unsigned x, unsigned& nloc, unsigned& nx) {
    const unsigned G = gridDim.x * gridDim.y * gridDim.z;
    unsigned sum, cnt, mine, sp = 0u;
    for (;;) {
        sum = 0u; cnt = 0u; mine = 0u;
#pragma unroll
        for (unsigned j = 0; j < 16; ++j) { const unsigned c = xb_ld(&bar[XB_XCNT(j)]); sum += c; cnt += (c > 0u) ? 1u : 0u; mine = (j == x) ? c : mine; }
        if (sum == G) break;
        __builtin_amdgcn_s_sleep(1);
        if ((++sp & 255u) == 0u) { if (xb_ld(&bar[XB_TMO])) break; if (sp > XB_SPIN_CAP) { atomicAdd(&bar[XB_TMO], 1u); break; } }
    }
    nloc = mine > 0u ? mine : 1u; nx = cnt > 0u ? cnt : 1u;
}
__device__ __forceinline__ void xcd_barrier(const XcdBarrier& b) {
    asm volatile("s_waitcnt vmcnt(0)" ::: "memory");
    __syncthreads();
    if (threadIdx.x == 0) {
        unsigned* bar = b.bar;
        __builtin_amdgcn_s_waitcnt(0);
        unsigned nloc = b.st[0], nx = b.st[1];
        if (nloc == 0u) { xcd_barrier_complete(bar, b.x, nloc, nx); b.st[0] = nloc; b.st[1] = nx; }
        const unsigned old = xb_add(&bar[XB_XSUB(b.x)], 1u);
        const unsigned gen = old / nloc;
        if (old + 1u == (gen + 1u) * nloc) {
            __builtin_amdgcn_fence(__ATOMIC_RELEASE, "agent");
            asm volatile("s_waitcnt vmcnt(0)" ::: "memory");
            const unsigned og = xb_add(&bar[XB_TOP], 1u);
            const unsigned tg = og / nx;
            if (og + 1u == (tg + 1u) * nx) xb_add(&bar[XB_TOPGEN], 1u);
            else XB_SPIN(xb_ld(&bar[XB_TOPGEN]) == tg, bar);
            __builtin_amdgcn_fence(__ATOMIC_ACQUIRE, "agent");
            xb_add(&bar[XB_XGEN(b.x)], 1u);
            asm volatile("s_waitcnt vmcnt(0)" ::: "memory");
        } else {
            XB_SPIN(xb_ld(&bar[XB_XGEN(b.x)]) == gen, bar);
            __builtin_amdgcn_fence(__ATOMIC_ACQUIRE, "agent");
            asm volatile("s_waitcnt vmcnt(0)" ::: "memory");
        }
    }
    __syncthreads();
}

enum { I_XP = 0, I_XS, I_PP, I_PS, I_CK, I_CV, I_CLF, I_SRE, I_SIM, I_GIN, I_WIN, I_BF, I_ARE, I_AIM, I_LDT, I_BRE, I_BIM, I_CRE, I_CIM, I_DSK, I_WGLU, I_WOUT, I_WPE, I_GPE, I_WPG, I_GFIN, N_IN };
struct Args { const float* in[N_IN]; float* out; unsigned char* ws; int ph_lo, ph_hi; };
typedef const __attribute__((address_space(4))) Args* KArgs;
__device__ __forceinline__ KArgs launder_kernarg() { KArgs p = (KArgs)__builtin_amdgcn_kernarg_segment_ptr(); asm volatile("" : "+s"(p)); return p; }

using pg8::Unit; using pg8::BM; using pg8::HALF; using pg8::cvt_pk_bf16; using pg8::pack8f; using pg8::bf_lo; using pg8::bf_hi; using pg8::sigmoidf_; using pg8::siluf_; using pg8::gelu_tanh_;
#define EPI_ARGS const f32x4 (&acc)[2][2][4][2], const Unit& u, int wr, int wc, int fr, int fq
struct EpiInProj { static constexpr bool PERM = true, AFTER_DRAIN = false;
    bf16 *Q, *K, *V, *SGA, *SGS, *UH; float *kp, *vp, *ks, *vs; float *QSS, *KSS;
    __device__ __forceinline__ void operator()(EPI_ARGS) const {
        const int seg = u.pn >> 2, csb = (u.pn & 3) * 256 + wc * 32 + 8 * fq, row0 = u.pm * BM + wr * 64 + fr;
        if (seg == 0 || seg == 3 || seg == 5) {
            bf16* dst = seg == 0 ? Q : (seg == 3 ? SGA : SGS);
#pragma unroll
            for (int ai = 0; ai < 2; ++ai)
#pragma unroll
                for (int m = 0; m < 4; ++m) { bf16* rowp = dst + (size_t)(row0 + ai * HALF + m * 16) * 1024 + csb;
#pragma unroll
                    for (int bj = 0; bj < 2; ++bj) { f32x4 v0 = acc[ai][bj][m][0], v1 = acc[ai][bj][m][1];
                        if (seg != 0) { for (int i = 0; i < 4; ++i) { v0[i] = siluf_(v0[i]); v1[i] = siluf_(v1[i]); } }
                        else { float ss = (v0[0] * v0[0] + v0[1] * v0[1]) + (v0[2] * v0[2] + v0[3] * v0[3]) + (v1[0] * v1[0] + v1[1] * v1[1]) + (v1[2] * v1[2] + v1[3] * v1[3]);
                            ss += __shfl_xor(ss, 16); ss += __shfl_xor(ss, 32);
                            if (fq == 0) QSS[((size_t)(row0 + ai * HALF + m * 16) * 8 + (u.pn & 3) * 2 + bj) * 4 + wc] = ss; }
                        *(v4u*)(rowp + bj * HALF) = pack8f(v0, v1); } }
        } else if (seg == 1 || seg == 2) {
            bf16* dst = seg == 1 ? K : V; float* o32 = u.pm < MP / BM ? (seg == 1 ? kp : vp) : (seg == 1 ? ks : vs) - (size_t)MP * 1024;
#pragma unroll
            for (int ai = 0; ai < 2; ++ai)
#pragma unroll
                for (int m = 0; m < 4; ++m) { const size_t ro = (size_t)(row0 + ai * HALF + m * 16) * 1024 + csb;
#pragma unroll
                    for (int bj = 0; bj < 2; ++bj) { const f32x4 v0 = acc[ai][bj][m][0], v1 = acc[ai][bj][m][1];
                        if (seg == 1) { float ss = (v0[0] * v0[0] + v0[1] * v0[1]) + (v0[2] * v0[2] + v0[3] * v0[3]) + (v1[0] * v1[0] + v1[1] * v1[1]) + (v1[2] * v1[2] + v1[3] * v1[3]);
                            ss += __shfl_xor(ss, 16); ss += __shfl_xor(ss, 32);
                            if (fq == 0) KSS[((size_t)(row0 + ai * HALF + m * 16) * 8 + (u.pn & 3) * 2 + bj) * 4 + wc] = ss; }
                        *(v4u*)(dst + ro + bj * HALF) = pack8f(v0, v1); *(f32x4*)(o32 + ro + bj * HALF) = v0; *(f32x4*)(o32 + ro + bj * HALF + 4) = v1; } }
        } else {
#pragma unroll
            for (int ai = 0; ai < 2; ++ai)
#pragma unroll
                for (int m = 0; m < 4; ++m) { const int row = row0 + ai * HALF + m * 16, chunk = row >> 5, s = row & 31;
#pragma unroll
                    for (int bj = 0; bj < 2; ++bj) { const int cs = csb + bj * HALF, g = cs >> 4, c0 = cs & 15;
                        *(v4u*)(UH + ((size_t)g * UHROWS + chunk) * UHLD + s * 16 + c0) = pack8f(acc[ai][bj][m][0], acc[ai][bj][m][1]); } }
        }
    }
};
struct EpiPle { static constexpr bool PERM = true, AFTER_DRAIN = false;
    bf16* E; float* ESS;
    __device__ __forceinline__ void operator()(EPI_ARGS) const {
        const int col0 = u.pn * BM + wc * 32 + 8 * fq, row0 = u.pm * BM + wr * 64 + fr;
#pragma unroll
        for (int ai = 0; ai < 2; ++ai)
#pragma unroll
            for (int m = 0; m < 4; ++m) { const int row = row0 + ai * HALF + m * 16; float ss = 0.f;
#pragma unroll
                for (int bj = 0; bj < 2; ++bj) { const f32x4 v0 = acc[ai][bj][m][0], v1 = acc[ai][bj][m][1];
                    ss += (v0[0] * v0[0] + v0[1] * v0[1]) + (v0[2] * v0[2] + v0[3] * v0[3]) + (v1[0] * v1[0] + v1[1] * v1[1]) + (v1[2] * v1[2] + v1[3] * v1[3]);
                    *(v4u*)(E + (size_t)row * DM + col0 + bj * HALF) = pack8f(v0, v1); }
                ss += __shfl_xor(ss, 16); ss += __shfl_xor(ss, 32);
                if (fq == 0) ESS[(size_t)row * 32 + u.pn * 4 + wc] = ss; }
    }
};
struct EpiGlu { static constexpr bool PERM = true, AFTER_DRAIN = false;
    const bf16 *YACT, *SGS; bf16* MIXED;
    __device__ __forceinline__ void operator()(EPI_ARGS) const {
        const int col0 = u.pn * BM + wc * 32 + 8 * fq, row0 = u.pm * BM + wr * 64 + fr;
#pragma unroll
        for (int ai = 0; ai < 2; ++ai)
#pragma unroll
            for (int m = 0; m < 4; ++m) { const int row = row0 + ai * HALF + m * 16;
#pragma unroll
                for (int bj = 0; bj < 2; ++bj) { const size_t o = (size_t)row * 1024 + col0 + bj * HALF;
                    const v4u ya = *(const v4u*)(YACT + o), sg = *(const v4u*)(SGS + o); f32x4 v0 = acc[ai][bj][m][0], v1 = acc[ai][bj][m][1];
                    v0[0] = bf_lo(ya.x) * sigmoidf_(v0[0]) * bf_lo(sg.x); v0[1] = bf_hi(ya.x) * sigmoidf_(v0[1]) * bf_hi(sg.x);
                    v0[2] = bf_lo(ya.y) * sigmoidf_(v0[2]) * bf_lo(sg.y); v0[3] = bf_hi(ya.y) * sigmoidf_(v0[3]) * bf_hi(sg.y);
                    v1[0] = bf_lo(ya.z) * sigmoidf_(v1[0]) * bf_lo(sg.z); v1[1] = bf_hi(ya.z) * sigmoidf_(v1[1]) * bf_hi(sg.z);
                    v1[2] = bf_lo(ya.w) * sigmoidf_(v1[2]) * bf_lo(sg.w); v1[3] = bf_hi(ya.w) * sigmoidf_(v1[3]) * bf_hi(sg.w);
                    *(v4u*)(MIXED + (size_t)row * DM + 1024 + col0 + bj * HALF) = pack8f(v0, v1); } }
    }
};
struct EpiOut { static constexpr bool PERM = true, AFTER_DRAIN = false;
    const float *xp, *xs; float *hp, *hs; bf16* HB;
    __device__ __forceinline__ void operator()(EPI_ARGS) const {
        const int col0 = u.pn * BM + wc * 32 + 8 * fq, row0 = u.pm * BM + wr * 64 + fr;
        const bool pr = u.pm < MP / BM; const float* xb = pr ? xp : xs - (size_t)MP * DM; float* hb = pr ? hp : hs - (size_t)MP * DM;
#pragma unroll
        for (int ai = 0; ai < 2; ++ai)
#pragma unroll
            for (int m = 0; m < 4; ++m) { const int row = row0 + ai * HALF + m * 16;
#pragma unroll
                for (int bj = 0; bj < 2; ++bj) { const size_t o = (size_t)row * DM + col0 + bj * HALF;
                    const f32x4 v0 = acc[ai][bj][m][0] + *(const f32x4*)(xb + o), v1 = acc[ai][bj][m][1] + *(const f32x4*)(xb + o + 4);
                    *(f32x4*)(hb + o) = v0; *(f32x4*)(hb + o + 4) = v1; *(v4u*)(HB + o) = pack8f(v0, v1); } }
    }
};
struct EpiPg { static constexpr bool PERM = true, AFTER_DRAIN = false;
    float *hp, *hs; const bf16* E; const float *RSTDE, *gpe; float* H2SS;
    __device__ __forceinline__ void operator()(EPI_ARGS) const {
        const int col0 = u.pn * BM + wc * 32 + 8 * fq, row0 = u.pm * BM + wr * 64 + fr;
        float* hb = u.pm < MP / BM ? hp : hs - (size_t)MP * DM;
        f32x4 gp[2][2];
#pragma unroll
        for (int bj = 0; bj < 2; ++bj) { gp[bj][0] = *(const f32x4*)(gpe + col0 + bj * HALF); gp[bj][1] = *(const f32x4*)(gpe + col0 + bj * HALF + 4); }
#pragma unroll
        for (int ai = 0; ai < 2; ++ai)
#pragma unroll
            for (int m = 0; m < 4; ++m) { const int row = row0 + ai * HALF + m * 16; const float rs = RSTDE[row]; float ss = 0.f;
#pragma unroll
                for (int bj = 0; bj < 2; ++bj) { const size_t o = (size_t)row * DM + col0 + bj * HALF;
                    const v4u e = *(const v4u*)(E + o); const f32x4 h0 = *(const f32x4*)(hb + o), h1 = *(const f32x4*)(hb + o + 4); const f32x4 a0 = acc[ai][bj][m][0], a1 = acc[ai][bj][m][1];
                    f32x4 v0, v1;
                    v0[0] = h0[0] + bf_lo(e.x) * rs * gp[bj][0][0] * sigmoidf_(a0[0]); v0[1] = h0[1] + bf_hi(e.x) * rs * gp[bj][0][1] * sigmoidf_(a0[1]);
                    v0[2] = h0[2] + bf_lo(e.y) * rs * gp[bj][0][2] * sigmoidf_(a0[2]); v0[3] = h0[3] + bf_hi(e.y) * rs * gp[bj][0][3] * sigmoidf_(a0[3]);
                    v1[0] = h1[0] + bf_lo(e.z) * rs * gp[bj][1][0] * sigmoidf_(a1[0]); v1[1] = h1[1] + bf_hi(e.z) * rs * gp[bj][1][1] * sigmoidf_(a1[1]);
                    v1[2] = h1[2] + bf_lo(e.w) * rs * gp[bj][1][2] * sigmoidf_(a1[2]); v1[3] = h1[3] + bf_hi(e.w) * rs * gp[bj][1][3] * sigmoidf_(a1[3]);
                    ss += (v0[0] * v0[0] + v0[1] * v0[1]) + (v0[2] * v0[2] + v0[3] * v0[3]) + (v1[0] * v1[0] + v1[1] * v1[1]) + (v1[2] * v1[2] + v1[3] * v1[3]);
                    *(f32x4*)(hb + o) = v0; *(f32x4*)(hb + o + 4) = v1; }
                ss += __shfl_xor(ss, 16); ss += __shfl_xor(ss, 32);
                if (fq == 0) H2SS[(size_t)row * 32 + u.pn * 4 + wc] = ss; }
    }
};
struct EpiSsmS { static constexpr bool PERM = false, AFTER_DRAIN = false;
    float* SBUF;
    __device__ __forceinline__ void operator()(EPI_ARGS) const {
        float* base = SBUF + (size_t)(u.g * 5 + u.pm) * 256 * 128; const int col0 = wc * 32 + 4 * fq, row0 = wr * 64 + fr;
#pragma unroll
        for (int ai = 0; ai < 2; ++ai)
#pragma unroll
            for (int m = 0; m < 4; ++m)
#pragma unroll
                for (int n = 0; n < 2; ++n) *(f32x4*)(base + (size_t)(row0 + ai * HALF + m * 16) * 128 + col0 + n * 16) = acc[ai][0][m][n];
    }
};
struct EpiSsmY { static constexpr bool PERM = true, AFTER_DRAIN = false;
    bf16* YACT;
    __device__ __forceinline__ void operator()(EPI_ARGS) const {
        const int n0 = u.pn * BM + wc * 32 + 8 * fq, row0 = wr * 64 + fr;
#pragma unroll
        for (int ai = 0; ai < 2; ++ai)
#pragma unroll
            for (int m = 0; m < 4; ++m) { const int r = row0 + ai * HALF + m * 16;
                if (u.pm < 4 || r < DECB) {
#pragma unroll
                    for (int bj = 0; bj < 2; ++bj) { const int n = n0 + bj * HALF, s = n >> 4, c0 = n & 15; const int tok = (u.pm < 4 ? u.pm * SEQ : MP) + r * CHUNK + s;
                        f32x4 v0 = acc[ai][bj][m][0], v1 = acc[ai][bj][m][1];
                        for (int i = 0; i < 4; ++i) { v0[i] = gelu_tanh_(v0[i]); v1[i] = gelu_tanh_(v1[i]); }
                        *(v4u*)(YACT + (size_t)tok * DSSM + u.g * 16 + c0) = pack8f(v0, v1); } } }
    }
};
struct SsmSched { const bf16* UH; const bf16* Bt; size_t bgrp, btile; int it0, it1, nit, upi;
    __device__ bool next(int i, Unit& u) const { if (i >= nit * upi) return false; const int li = i / upi, item = li == 0 ? it0 : it1; u.g = item / 5; u.pm = item % 5; u.pn = i % upi; return true; }
    __device__ __forceinline__ const char* a_ptr(const Unit& u) const { return (const char*)(UH + ((size_t)u.g * UHROWS + (size_t)u.pm * 256) * UHLD); }
    __device__ __forceinline__ const char* b_ptr(const Unit& u) const { return (const char*)Bt + (size_t)u.g * bgrp + (size_t)u.pn * btile; }
    __device__ __forceinline__ void a_ready(const Unit&) const {}
    __device__ __forceinline__ void done(const Unit&) const {}
};

__device__ __forceinline__ void p0_transpose_item(const float* W, int ldw, int src_col0, bf16* WT, int K, int dst_row0, int k0, LAS float* scr, int lane) {
#pragma unroll 8
    for (int i = 0; i < 32; ++i) { const int kk = 2 * i + (lane >> 5); scr[kk * 33 + (lane & 31)] = W[(size_t)(k0 + kk) * ldw + src_col0 + (lane & 31)]; }
    LDS_WAIT(); asm volatile("" ::: "memory");
    const int c = lane & 7;
#pragma unroll
    for (int j = 0; j < 4; ++j) { const int n = (lane >> 3) + 8 * j; const LAS float* s = scr + (8 * c) * 33 + n;
        v4u o; o.x = pk2(s[0 * 33], s[1 * 33]); o.y = pk2(s[2 * 33], s[3 * 33]); o.z = pk2(s[4 * 33], s[5 * 33]); o.w = pk2(s[6 * 33], s[7 * 33]);
        *(GAS v4u*)(WT + (size_t)(dst_row0 + n) * K + k0 + 8 * c) = o; }
    LDS_WAIT(); asm volatile("" ::: "memory");
}
__device__ __forceinline__ void ssm_tables(KArgs a, LAS unsigned char* lds, int g) {
    const int tid = threadIdx.x;
    LAS float* bbr = (LAS float*)lds;
    LAS float* bbi = bbr + 1024;
    LAS float* Cr = bbi + 1024;
    LAS float* Ci = Cr + 1024;
    LAS float* apr = Ci + 1024;
    LAS float* api = apr + 33 * 64;
    LAS float* Kc = api + 33 * 64;
    if (tid < 64) { const int p = tid;
        const double dt = exp((double)a->in[I_LDT][g]);
        const double ar = a->in[I_ARE][g * 64 + p], ai = a->in[I_AIM][g * 64 + p];
        const double mag = exp(ar * dt), ang = ai * dt; const double abr = mag * cos(ang), abi = mag * sin(ang);
        const double nr = abr - 1.0, ni = abi, den = ar * ar + ai * ai; const double cr = (nr * ar + ni * ai) / den, ci = (ni * ar - nr * ai) / den;
        for (int c = 0; c < 16; ++c) { const double br = a->in[I_BRE][(size_t)(g * 64 + p) * 16 + c], bi = a->in[I_BIM][(size_t)(g * 64 + p) * 16 + c];
            bbr[p * 16 + c] = (float)(cr * br - ci * bi); bbi[p * 16 + c] = (float)(cr * bi + ci * br); }
        double pr = 1.0, pi = 0.0;
        for (int t = 0; t <= 32; ++t) { apr[t * 64 + p] = (float)pr; api[t * 64 + p] = (float)pi; const double nr2 = pr * abr - pi * abi, ni2 = pr * abi + pi * abr; pr = nr2; pi = ni2; }
        float* A32 = (float*)(a->ws + WS_A32); A32[(g * 64 + p) * 2] = apr[32 * 64 + p]; A32[(g * 64 + p) * 2 + 1] = api[32 * 64 + p];
    }
    for (int e = tid; e < 1024; e += NTHR) { Cr[e] = a->in[I_CRE][(size_t)g * 1024 + e]; Ci[e] = a->in[I_CIM][(size_t)g * 1024 + e]; }
    __syncthreads();
    for (int e = tid; e < 8192; e += NTHR) { const int t = e >> 8, c = (e >> 4) & 15, c2 = e & 15; float sum = 0.f;
        for (int p = 0; p < 64; ++p) { const float car = Cr[c * 64 + p] * apr[t * 64 + p] - Ci[c * 64 + p] * api[t * 64 + p], cai = Cr[c * 64 + p] * api[t * 64 + p] + Ci[c * 64 + p] * apr[t * 64 + p];
            sum += car * bbr[p * 16 + c2] - cai * bbi[p * 16 + c2]; }
        if (t == 0 && c == c2) sum += a->in[I_DSK][g * 16 + c];
        Kc[e] = sum; }
    __syncthreads();
    bf16* MW = (bf16*)(a->ws + WS_MW_T) + (size_t)g * 512 * UHLD;
    for (int idx = tid; idx < 512 * 80; idx += NTHR) { const int n = idx / 80, k0 = (idx % 80) * 8, s = n >> 4, c = n & 15; float v[8];
        if (k0 < 512) { const int s2 = k0 >> 4, c0 = k0 & 15;
#pragma unroll
            for (int j = 0; j < 8; ++j) v[j] = s2 <= s ? Kc[((s - s2) * 16 + c) * 16 + c0 + j] : 0.f;
        } else if (k0 < 576) {
#pragma unroll
            for (int j = 0; j < 8; ++j) { const int p = k0 - 512 + j; v[j] = Cr[c * 64 + p] * apr[(s + 1) * 64 + p] - Ci[c * 64 + p] * api[(s + 1) * 64 + p]; }
        } else {
#pragma unroll
            for (int j = 0; j < 8; ++j) { const int p = k0 - 576 + j; v[j] = -(Cr[c * 64 + p] * api[(s + 1) * 64 + p] + Ci[c * 64 + p] * apr[(s + 1) * 64 + p]); }
        }
        v4u o; o.x = pk2(v[0], v[1]); o.y = pk2(v[2], v[3]); o.z = pk2(v[4], v[5]); o.w = pk2(v[6], v[7]);
        *(GAS v4u*)(MW + (size_t)n * UHLD + k0) = o; }
    bf16* BP = (bf16*)(a->ws + WS_BP_T) + (size_t)g * 256 * 512;
    for (int idx = tid; idx < 256 * 64; idx += NTHR) { const int n = idx >> 6, k0 = (idx & 63) * 8, s2 = k0 >> 4, c0 = k0 & 15; float v[8];
#pragma unroll
        for (int j = 0; j < 8; ++j) {
            if (n < 64) v[j] = apr[(31 - s2) * 64 + n] * bbr[n * 16 + c0 + j] - api[(31 - s2) * 64 + n] * bbi[n * 16 + c0 + j];
            else if (n < 128) { const int p = n - 64; v[j] = apr[(31 - s2) * 64 + p] * bbi[p * 16 + c0 + j] + api[(31 - s2) * 64 + p] * bbr[p * 16 + c0 + j]; }
            else v[j] = 0.f; }
        v4u o; o.x = pk2(v[0], v[1]); o.y = pk2(v[2], v[3]); o.z = pk2(v[4], v[5]); o.w = pk2(v[6], v[7]);
        *(GAS v4u*)(BP + (size_t)n * 512 + k0) = o; }
    __syncthreads();
}
__device__ __forceinline__ float log_sigmoid_(float z) { return z >= 0.f ? -log1pf(expf(-z)) : z - log1pf(expf(z)); }
__device__ __forceinline__ void phase0(KArgs a, LAS unsigned char* lds) {
    const int tid = threadIdx.x, lane = tid & 63, wave = __builtin_amdgcn_readfirstlane(tid >> 6);
    const int gw = blockIdx.x * NWAVES + wave, NGW = gridDim.x * NWAVES;
    if (blockIdx.x < NG) ssm_tables(a, lds, blockIdx.x);
    { LAS float* scr = (LAS float*)(lds + wave * 16384);
      constexpr int I_IN = 32 * 192, I_GLU = 16 * 32, I_OUT = 32 * 64, I_PE = 4 * 64, I_PG = 32 * 64, NITEMS = I_IN + I_GLU + I_OUT + I_PE + I_PG;
      for (int it = gw; it < NITEMS; it += NGW) { int r = it;
          if (r < I_IN) { const int kb = r / 192, nb = r % 192; p0_transpose_item(a->in[I_WIN], DIN, 32 * nb + (nb >= 96 ? 8 : 0), (bf16*)(a->ws + WS_WIN_T), DM, 32 * nb, 64 * kb, scr, lane); continue; } r -= I_IN;
          if (r < I_GLU) { const int kb = r / 32, nb = r % 32; p0_transpose_item(a->in[I_WGLU], DSSM, 32 * nb, (bf16*)(a->ws + WS_WGLU_T), DSSM, 32 * nb, 64 * kb, scr, lane); continue; } r -= I_GLU;
          if (r < I_OUT) { const int kb = r / 64, nb = r % 64; p0_transpose_item(a->in[I_WOUT], DM, 32 * nb, (bf16*)(a->ws + WS_WOUT_T), DM, 32 * nb, 64 * kb, scr, lane); continue; } r -= I_OUT;
          if (r < I_PE) { const int kb = r / 64, nb = r % 64; p0_transpose_item(a->in[I_WPE], DM, 32 * nb, (bf16*)(a->ws + WS_WPE_T), DPLE, 32 * nb, 64 * kb, scr, lane); continue; } r -= I_PE;
          { const int kb = r / 64, nb = r % 64; p0_transpose_item(a->in[I_WPG], DM, 32 * nb, (bf16*)(a->ws + WS_WPG_T), DM, 32 * nb, 64 * kb, scr, lane); } } }
    __syncthreads();
    LAS float* wfT = (LAS float*)lds;
    for (int e = tid; e < DM * NH; e += NTHR) { const int k = e >> 3, h = e & 7; wfT[h * DM + k] = a->in[I_WIN][(size_t)k * DIN + OFF_F + h]; }
    __syncthreads();
    f32x4 gi[8];
#pragma unroll
    for (int j = 0; j < 8; ++j) gi[j] = *(const f32x4*)(a->in[I_GIN] + 256 * j + 4 * lane);
    const float bfh = a->in[I_BF][lane & 7];
    float* LOGF = (float*)(a->ws + WS_LOGF);
    for (int row = gw; row < MT; row += NGW) {
        const bool pr = row < MP;
        const float* xr = pr ? a->in[I_XP] + (size_t)row * DM : a->in[I_XS] + (size_t)(row - MP) * DM;
        f32x4 v[8]; float ss = 0.f;
#pragma unroll
        for (int j = 0; j < 8; ++j) { v[j] = *(const f32x4*)(xr + 256 * j + 4 * lane); ss += (v[j][0] * v[j][0] + v[j][1] * v[j][1]) + (v[j][2] * v[j][2] + v[j][3] * v[j][3]); }
        const float rstd = 1.0f / sqrtf(wave_sum(ss) * (1.0f / DM) + EPS);
        bf16* xo = (bf16*)(a->ws + WS_XN) + (size_t)row * DM;
#pragma unroll
        for (int j = 0; j < 8; ++j) { v[j] = v[j] * rstd * gi[j]; v2u w; w.x = pk2(v[j][0], v[j][1]); w.y = pk2(v[j][2], v[j][3]); *(GAS v2u*)(xo + 256 * j + 4 * lane) = w; }
        float mine = 0.f;
#pragma unroll 1
        for (int h = 0; h < 8; ++h) { float s = 0.f;
#pragma unroll
            for (int j = 0; j < 8; ++j) { const f32x4 w = *(const LAS f32x4*)(wfT + h * DM + 256 * j + 4 * lane); s += (v[j][0] * w[0] + v[j][1] * w[1]) + (v[j][2] * w[2] + v[j][3] * w[3]); }
            s = wave_sum(s); mine = (lane & 7) == h ? s : mine; }
        if (lane < 8) { const float lf = log_sigmoid_(mine + bfh); LOGF[(size_t)row * 8 + lane] = lf;
            (pr ? a->out + O_LFP + (size_t)row * 8 : a->out + O_LFS + (size_t)(row - MP) * 8)[lane] = lf; }
        const float* prow = pr ? a->in[I_PP] + (size_t)row * DPLE : a->in[I_PS] + (size_t)(row - MP) * DPLE;
        const f32x4 pv = *(const f32x4*)(prow + 4 * lane); v2u w; w.x = pk2(pv[0], pv[1]); w.y = pk2(pv[2], pv[3]);
        *(GAS v2u*)((bf16*)(a->ws + WS_PB) + (size_t)row * DPLE + 4 * lane) = w;
    }
}
__device__ __forceinline__ void forget_cumsum(KArgs a, LAS unsigned char* lds) {
    const int bid = blockIdx.x, tid = threadIdx.x;
    if (bid < NB + DECB) {
        LAS double* sseg = (LAS double*)lds;
        const int h = tid & 7, seg = tid >> 3; const float* LOGF = (const float*)(a->ws + WS_LOGF);
        const bool pr = bid < NB; const int b = pr ? bid : bid - NB, n = pr ? SEQ : PAST + DECS, L = pr ? 128 : 65;
        const float* s0 = pr ? LOGF + (size_t)b * SEQ * 8 + h : a->in[I_CLF] + (size_t)b * PAST * 8 + h;
        const float* s1 = LOGF + ((size_t)MP + (size_t)b * DECS) * 8 + h;
        const int n0 = pr ? SEQ : PAST;
        float* out = pr ? (float*)(a->ws + WS_CP) + (size_t)(b * NH + h) * SEQ : (float*)(a->ws + WS_CS) + (size_t)(b * NH + h) * CSLD;
        const int t0 = seg * L, t1 = (t0 + L < n) ? t0 + L : n;
        double s = 0.0;
        for (int t = t0; t < t1; ++t) s += (double)(t < n0 ? s0[(size_t)t * 8] : s1[(size_t)(t - n0) * 8]);
        sseg[seg * 8 + h] = s; __syncthreads();
        double pre = 0.0; for (int j = 0; j < seg; ++j) pre += sseg[j * 8 + h];
        for (int t = t0; t < t1; ++t) { pre += (double)(t < n0 ? s0[(size_t)t * 8] : s1[(size_t)(t - n0) * 8]); out[t] = (float)(pre * 11.313708498984761); }
        if (!pr && seg == 63) { const float last = (float)(pre * 11.313708498984761); for (int t = n; t < CSLD; ++t) out[t] = last; }
        __syncthreads();
    }
}
__device__ __forceinline__ void ssm_scan(KArgs a, int item, int lane) {
    const int g = item / 5, u = item % 5, p = lane;
    const float* S = (const float*)(a->ws + WS_SBUF) + (size_t)item * 256 * 128;
    bf16* UH = (bf16*)(a->ws + WS_UH) + ((size_t)g * UHROWS + (size_t)u * 256) * UHLD;
    const float a32r = ((const float*)(a->ws + WS_A32))[(g * 64 + p) * 2], a32i = ((const float*)(a->ws + WS_A32))[(g * 64 + p) * 2 + 1];
    if (u < 4) {
        float hr = 0.f, hi = 0.f;
        for (int j = 0; j < 256; ++j) {
            UH[(size_t)j * UHLD + 512 + p] = (bf16)f2bf(hr); UH[(size_t)j * UHLD + 576 + p] = (bf16)f2bf(hi);
            const float sr = S[j * 128 + p], si = S[j * 128 + 64 + p];
            const float nr = a32r * hr - a32i * hi + sr, ni = a32r * hi + a32i * hr + si; hr = nr; hi = ni; }
        a->out[O_SRP + (size_t)(u * NG + g) * NST + p] = hr; a->out[O_SIP + (size_t)(u * NG + g) * NST + p] = hi;
    } else {
        for (int j = 0; j < DECB; ++j) {
            const float hr = a->in[I_SRE][(size_t)(j * NG + g) * NST + p], hi = a->in[I_SIM][(size_t)(j * NG + g) * NST + p];
            UH[(size_t)j * UHLD + 512 + p] = (bf16)f2bf(hr); UH[(size_t)j * UHLD + 576 + p] = (bf16)f2bf(hi);
            const float sr = S[j * 128 + p], si = S[j * 128 + 64 + p];
            a->out[O_SRS + (size_t)(j * NG + g) * NST + p] = a32r * hr - a32i * hi + sr; a->out[O_SIS + (size_t)(j * NG + g) * NST + p] = a32r * hi + a32i * hr + si; }
    }
}
constexpr float PRUNE_T = 36.0f;
__device__ __forceinline__ float dpp_max_step(float v, const int ctrl_sel) {
    int x = __float_as_int(v), y;
    if (ctrl_sel == 0) y = __builtin_amdgcn_update_dpp(x, x, 0xB1, 0xF, 0xF, false);
    else if (ctrl_sel == 1) y = __builtin_amdgcn_update_dpp(x, x, 0x4E, 0xF, 0xF, false);
    else if (ctrl_sel == 2) y = __builtin_amdgcn_update_dpp(x, x, 0x141, 0xF, 0xF, false);
    else y = __builtin_amdgcn_update_dpp(x, x, 0x140, 0xF, 0xF, false);
    return fmaxf(v, __int_as_float(y));
}
__device__ __forceinline__ float block_max(float v, LAS float* red, int lane, int wave) {
    v = dpp_max_step(v, 0); v = dpp_max_step(v, 1); v = dpp_max_step(v, 2); v = dpp_max_step(v, 3);
    const float w = fmaxf(fmaxf(__int_as_float(__builtin_amdgcn_readlane(__float_as_int(v), 0)), __int_as_float(__builtin_amdgcn_readlane(__float_as_int(v), 16))),
                          fmaxf(__int_as_float(__builtin_amdgcn_readlane(__float_as_int(v), 32)), __int_as_float(__builtin_amdgcn_readlane(__float_as_int(v), 48))));
    __syncthreads(); if (lane == 0) red[wave] = w; __syncthreads();
    float m = red[0];
#pragma unroll
    for (int k = 1; k < NWAVES; ++k) m = fmaxf(m, red[k]);
    return __uint_as_float(__builtin_amdgcn_readfirstlane(__float_as_uint(m)));
}
__device__ __forceinline__ float fox_kmax2(KArgs a, int bh, LAS float* red, int tid) {
    asm volatile("" : "+v"(tid));
    const int b = bh >> 3, h = bh & 7; const float* KSS = (const float*)(a->ws + WS_KSS); float m = 0.f;
    for (int t = tid; t < SEQ; t += NTHR) { const f32x4 v = *(const f32x4*)(KSS + ((size_t)(b * SEQ + t) * 8 + h) * 4); m = fmaxf(m, (v[0] + v[1]) + (v[2] + v[3])); }
    return block_max(m, red, tid & 63, tid >> 6);
}
__device__ __forceinline__ int fox_jlo(KArgs a, int bh, int qb, float kmax2, LAS float* red, int tid) {
    asm volatile("" : "+v"(tid));
    const int b = bh >> 3, h = bh & 7, P0 = qb * 256; const float* QSS = (const float*)(a->ws + WS_QSS); float q2 = 0.f;
    if (tid < 256) { const f32x4 v = *(const f32x4*)(QSS + ((size_t)(b * SEQ + P0 + tid) * 8 + h) * 4); q2 = (v[0] + v[1]) + (v[2] + v[3]); }
    const float qmax2 = block_max(q2, red, tid & 63, tid >> 6);
    const float B = sqrtf(qmax2 * kmax2) * att::SCALE * 1.02f;
    const float thr = (PRUNE_T + 2.0f * B) * 11.313708498984761f;
    const float* cp = (const float*)(a->ws + WS_CP) + (size_t)(b * NH + h) * SEQ;
    const bool skip = tid < 4 * qb && cp[64 * tid + 63] - cp[P0] > thr;
    const float cnt = (float)__popcll(__ballot(skip));
    __syncthreads(); if ((tid & 63) == 0) red[8 + (tid >> 6)] = cnt; __syncthreads();
    return __builtin_amdgcn_readfirstlane((int)(red[8] + red[9]));
}
__device__ __forceinline__ att::BlockRef<att::bf16> prompt_ref(KArgs a, int bh, int qb, int jlo) {
    const int b = bh >> 3, h = bh & 7; att::BlockRef<att::bf16> r;
    const size_t row0 = (size_t)b * SEQ + (size_t)qb * 256, key0 = (size_t)b * SEQ + (size_t)jlo * 64;
    r.Q = (const bf16*)(a->ws + WS_Q) + row0 * 1024 + h * HD; r.K = (const bf16*)(a->ws + WS_K) + key0 * 1024 + h * HD; r.V = (const bf16*)(a->ws + WS_V) + key0 * 1024 + h * HD;
    r.Kn = r.K; r.Vn = r.V; r.O = (bf16*)(a->ws + WS_MIXED) + row0 * DM + h * HD; r.G = (const bf16*)(a->ws + WS_SGA) + row0 * 1024 + h * HD;
    const float* cp = (const float*)(a->ws + WS_CP) + (size_t)(b * NH + h) * SEQ;
    r.CK = cp + jlo * 64; r.CQ = cp + qb * 256; r.np = 0x7fffffff; r.P0 = qb * 256 - jlo * 64; r.jhi = 4 * qb + 4 - jlo;
    return r;
}
__device__ __forceinline__ att::BlockRef<float> sample_ref(KArgs a, int bh) {
    const int b = bh >> 3, h = bh & 7; att::BlockRef<float> r;
    const size_t row0 = (size_t)MP + (size_t)b * DECS;
    r.Q = (const bf16*)(a->ws + WS_Q) + row0 * 1024 + h * HD; r.K = a->in[I_CK] + (size_t)b * PAST * 1024 + h * HD; r.V = a->in[I_CV] + (size_t)b * PAST * 1024 + h * HD;
    r.Kn = a->out + O_KS + (size_t)b * DECS * 1024 + h * HD; r.Vn = a->out + O_VS + (size_t)b * DECS * 1024 + h * HD;
    r.O = (bf16*)(a->ws + WS_MIXED) + row0 * DM + h * HD; r.G = (const bf16*)(a->ws + WS_SGA) + row0 * 1024 + h * HD;
    r.CK = (const float*)(a->ws + WS_CS) + (size_t)(b * NH + h) * CSLD; r.CQ = r.CK + PAST; r.np = PAST; r.P0 = PAST; r.jhi = (PAST + 64) / 64;
    return r;
}

__global__ void __launch_bounds__(NTHR, 2) fox_s5_fwd(Args args) {
    extern __shared__ __attribute__((aligned(16))) unsigned char lds_raw[];
    LAS unsigned char* lds = (LAS unsigned char*)lds_raw;
    const int G = gridDim.x, bid = blockIdx.x;
#define THREAD_IDS() int tid = threadIdx.x; asm volatile("" : "+v"(tid)); const int lane = tid & 63, wave = __builtin_amdgcn_readfirstlane(tid >> 6); (void)lane; (void)wave
    { THREAD_IDS(); for (int u = tid; u < (LDS_BYTES - LDSCTL_OFF) / 4; u += NTHR) ((LAS unsigned*)(lds + LDSCTL_OFF))[u] = 0u; }
    __syncthreads();
#if MK_ONE_LAUNCH
    XcdBarrier bar = xcd_barrier_post((unsigned*)(args.ws + WS_CTL) + CW_BAR, (volatile LAS unsigned*)(lds + MISC_OFF) + 8);
#define GRID_BAR() xcd_barrier(bar)
#else
#define GRID_BAR() do {} while (0)
#endif
    const int lo = args.ph_lo, hi = args.ph_hi;
#ifdef ONLY_PH
#define IN(k) ((k) == ONLY_PH && lo <= (k) && (k) < hi)
#else
#define IN(k) (lo <= (k) && (k) < hi)
#endif
#define BOTH(k) (IN(k) && IN((k) + 1))

    if (IN(0)) { KArgs A = launder_kernarg(); unsigned char* ws = A->ws; (void)ws; phase0(A, lds); if (BOTH(0)) GRID_BAR(); }

    if (IN(1)) { KArgs A = launder_kernarg(); unsigned char* ws = A->ws; (void)ws;
        forget_cumsum(A, lds);
        { pg8::Gemm g{DM, DM, DM}; pg8::StaticOrder S; S.init((const bf16*)(ws + WS_XN), (const bf16*)(ws + WS_WIN_T), DM, DM, MT, NIN, G, bid);
          EpiInProj E{(bf16*)(ws + WS_Q), (bf16*)(ws + WS_K), (bf16*)(ws + WS_V), (bf16*)(ws + WS_SGA), (bf16*)(ws + WS_SGS), (bf16*)(ws + WS_UH),
                      A->out + O_KP, A->out + O_VP, A->out + O_KS, A->out + O_VS, (float*)(ws + WS_QSS), (float*)(ws + WS_KSS)};
          pg8::gemm_phase<EpiInProj, pg8::StaticOrder, true, true>(lds + RING_OFF, g, S, E); }
        { pg8::Gemm g{DPLE, DPLE, DPLE}; pg8::StaticOrder S; S.init((const bf16*)(ws + WS_PB), (const bf16*)(ws + WS_WPE_T), DPLE, DPLE, MT, DM, G, bid);
          EpiPle E{(bf16*)(ws + WS_E), (float*)(ws + WS_ESS)};
          pg8::gemm_phase<EpiPle, pg8::StaticOrder, true, true>(lds + RING_OFF, g, S, E); }
        if (BOTH(1)) GRID_BAR();
    }

    if (IN(2)) { KArgs A = launder_kernarg(); unsigned char* ws = A->ws; (void)ws; THREAD_IDS();
#ifndef NO_SSM
        { const int it0 = bid, it1 = bid + G, nit = it0 < NSSM_ITEMS ? (it1 < NSSM_ITEMS ? 2 : 1) : 0;
          if (nit > 0) {
            { pg8::Gemm g{UHLD, 512, 512}; SsmSched S{(const bf16*)(ws + WS_UH), (const bf16*)(ws + WS_BP_T), (size_t)256 * 512 * 2, 0, it0, it1, nit, 1};
              EpiSsmS E{(float*)(ws + WS_SBUF)};
              pg8::gemm_phase<EpiSsmS, SsmSched, false, true>(lds + RING_OFF, g, S, E); }
            VM_WAIT(); __syncthreads();
            if (wave < nit) ssm_scan(A, wave == 0 ? it0 : it1, lane);
            VM_WAIT(); __syncthreads();
            { pg8::Gemm g{UHLD, UHLD, UHLD}; SsmSched S{(const bf16*)(ws + WS_UH), (const bf16*)(ws + WS_MW_T), (size_t)512 * UHLD * 2, (size_t)256 * UHLD * 2, it0, it1, nit, 2};
              EpiSsmY E{(bf16*)(ws + WS_YACT)};
              pg8::gemm_phase<EpiSsmY, SsmSched, false, true>(lds + RING_OFF, g, S, E); }
          } }
#endif
        __syncthreads();
#ifndef NO_PATT
        { att::Seam S; int L = bid; LAS float* red = (LAS float*)(lds + RING_OFF + 65536);
          if (L < 512) {
            int pass = 0; float km2 = fox_kmax2(A, L >> 4, red, tid);
            att::BlockRef<att::bf16> cur = prompt_ref(A, L >> 4, L & 15, fox_jlo(A, L >> 4, L & 15, km2, red, tid));
            att::fox_prime<att::bf16, false>(cur, (char*)lds_raw + RING_OFF, S);
            for (;;) {
                int Ln = L, passn = pass + 1; if (pass == 1) { passn = 0; Ln = L + G; }
                const bool last = Ln >= 512;
                const int qbn = passn == 0 ? (Ln & 15) : 31 - (Ln & 15); int jn = 0;
                if (!last) { if (passn == 0) km2 = fox_kmax2(A, Ln >> 4, red, tid); jn = fox_jlo(A, Ln >> 4, qbn, km2, red, tid); }
                const att::BlockRef<att::bf16> nxt = last ? cur : prompt_ref(A, Ln >> 4, qbn, jn);
                att::fox_block<att::bf16, false>(cur, nxt, (char*)lds_raw + RING_OFF, S);
                if (last) break;
                cur = nxt; L = Ln; pass = passn;
            } } }
#endif
        __syncthreads();
#ifndef NO_SATT
        { att::Seam S;
          for (int L = bid; L < DECB * NH; L += G) {
            const att::BlockRef<float> cur = sample_ref(A, L);
            att::fox_prime<float, true>(cur, (char*)lds_raw + RING_OFF, S);
            att::fox_block<float, true>(cur, cur, (char*)lds_raw + RING_OFF, S);
            VM_WAIT(); __syncthreads();
          } }
#endif
        if (BOTH(2)) GRID_BAR();
    }

    if (IN(3)) { KArgs A = launder_kernarg(); unsigned char* ws = A->ws; (void)ws; THREAD_IDS();
        { const int rpb = (MT + G - 1) / G; const int row = bid * rpb + tid;
          if (tid < rpb && row < MT) { const f32x4* p = (const f32x4*)((const float*)(ws + WS_ESS) + (size_t)row * 32); float ss = 0.f;
#pragma unroll
              for (int j = 0; j < 8; ++j) { const f32x4 v = p[j]; ss += (v[0] + v[1]) + (v[2] + v[3]); }
              ((float*)(ws + WS_RSTDE))[row] = 1.0f / sqrtf(ss * (1.0f / DM) + EPS); } }
        { pg8::Gemm g{DSSM, DSSM, DSSM}; pg8::StaticOrder S; S.init((const bf16*)(ws + WS_YACT), (const bf16*)(ws + WS_WGLU_T), DSSM, DSSM, MT, DSSM, G, bid);
          EpiGlu E{(const bf16*)(ws + WS_YACT), (const bf16*)(ws + WS_SGS), (bf16*)(ws + WS_MIXED)};
          pg8::gemm_phase<EpiGlu, pg8::StaticOrder, true, true>(lds + RING_OFF, g, S, E); }
        if (BOTH(3)) GRID_BAR();
    }

    if (IN(4)) { KArgs A = launder_kernarg(); unsigned char* ws = A->ws; (void)ws;
        { pg8::Gemm g{DM, DM, DM}; pg8::StaticOrder S; S.init((const bf16*)(ws + WS_MIXED), (const bf16*)(ws + WS_WOUT_T), DM, DM, MT, DM, G, bid);
          EpiOut E{A->in[I_XP], A->in[I_XS], A->out + O_YP, A->out + O_YS, (bf16*)(ws + WS_HB)};
          pg8::gemm_phase<EpiOut, pg8::StaticOrder, true, true>(lds + RING_OFF, g, S, E); }
        if (BOTH(4)) GRID_BAR();
    }

    if (IN(5)) { KArgs A = launder_kernarg(); unsigned char* ws = A->ws; (void)ws;
        { pg8::Gemm g{DM, DM, DM}; pg8::StaticOrder S; S.init((const bf16*)(ws + WS_HB), (const bf16*)(ws + WS_WPG_T), DM, DM, MT, DM, G, bid);
          EpiPg E{A->out + O_YP, A->out + O_YS, (const bf16*)(ws + WS_E), (const float*)(ws + WS_RSTDE), A->in[I_GPE], (float*)(ws + WS_H2SS)};
          pg8::gemm_phase<EpiPg, pg8::StaticOrder, true, true>(lds + RING_OFF, g, S, E); }
        if (BOTH(5)) GRID_BAR();
    }

    if (IN(6)) { KArgs A = launder_kernarg(); unsigned char* ws = A->ws; (void)ws; THREAD_IDS();
        const int gw = bid * NWAVES + wave, NGW = G * NWAVES;
        f32x4 gf[8];
#pragma unroll
        for (int j = 0; j < 8; ++j) gf[j] = *(const f32x4*)(A->in[I_GFIN] + 256 * j + 4 * lane);
        for (int row = gw; row < MT; row += NGW) {
            float ss = lane < 32 ? ((const float*)(ws + WS_H2SS))[(size_t)row * 32 + lane] : 0.f;
            const float rstd = 1.0f / sqrtf(wave_sum(ss) * (1.0f / DM) + EPS);
            float* yr = row < MP ? A->out + O_YP + (size_t)row * DM : A->out + O_YS + (size_t)(row - MP) * DM;
#pragma unroll
            for (int j = 0; j < 8; ++j) { f32x4 v = *(const f32x4*)(yr + 256 * j + 4 * lane); v = v * rstd * gf[j]; *(f32x4*)(yr + 256 * j + 4 * lane) = v; }
        }
    }
#undef IN
#undef BOTH
}
constexpr int NPHASE = 7;

extern "C" void kernel_launch(void* const* d_in, const int* in_sizes, int n_in, void* d_out, int out_size, void* d_ws, size_t ws_size, hipStream_t stream) {
    static int grid = 0;
    if (grid == 0) {
        if (n_in != N_IN || in_sizes[0] != MP * DM || (size_t)out_size != O_END || ws_size < WS_END) {
            fprintf(stderr, "kernel_launch: unexpected shapes (n_in %d, in0 %d, out %d, ws %zu); nothing launched\n", n_in, n_in > 0 ? in_sizes[0] : -1, out_size, ws_size); grid = -1; return; }
        int dev = 0, cus = 0, per_cu = 0;
        if (hipGetDevice(&dev) != hipSuccess || hipDeviceGetAttribute(&cus, hipDeviceAttributeMultiprocessorCount, dev) != hipSuccess) { grid = -1; return; }
        if (hipFuncSetAttribute((const void*)fox_s5_fwd, hipFuncAttributeMaxDynamicSharedMemorySize, LDS_BYTES) != hipSuccess) { fprintf(stderr, "kernel_launch: hipFuncSetAttribute failed\n"); grid = -1; return; }
        if (hipOccupancyMaxActiveBlocksPerMultiprocessor(&per_cu, (const void*)fox_s5_fwd, NTHR, LDS_BYTES) != hipSuccess || per_cu < 1)
            fprintf(stderr, "kernel_launch: note: occupancy query reports %d workgroups per CU\n", per_cu);
        (void)hipGetLastError();
        grid = cus;
    }
    if (grid < 0) return;
    (void)hipMemsetAsync((char*)d_ws + WS_CTL, 0, CTL_ZERO_BYTES, stream);
    Args a{};
    for (int i = 0; i < N_IN; ++i) a.in[i] = (const float*)d_in[i];
    a.out = (float*)d_out; a.ws = (unsigned char*)d_ws;
#if MK_ONE_LAUNCH
    a.ph_lo = 0; a.ph_hi = NPHASE;
    hipLaunchKernelGGL(fox_s5_fwd, dim3(grid), dim3(NTHR), LDS_BYTES, stream, a);
#else
    for (int ph = 0; ph < NPHASE; ++ph) { a.ph_lo = ph; a.ph_hi = ph + 1; hipLaunchKernelGGL(fox_s5_fwd, dim3(grid), dim3(NTHR), LDS_BYTES, stream, a);
#ifdef PROBE_REP
        if (ph == PROBE_REP) { const int r0 = PROBE_REP >= 5 ? 4 : PROBE_REP;
            for (int p2 = r0; p2 <= PROBE_REP; ++p2) { a.ph_lo = p2; a.ph_hi = p2 + 1; hipLaunchKernelGGL(fox_s5_fwd, dim3(grid), dim3(NTHR), LDS_BYTES, stream, a); } }
#endif
    }
#endif
}
```

```cpp
#include <hip/hip_runtime.h>
#include <cstdio>
#include <cstdint>

#ifndef MK_ONE_LAUNCH
#define MK_ONE_LAUNCH 1
#endif
#ifndef DBG_GP
#define DBG_GP 0
#endif

namespace pg8 {
#define PG8_LAS __attribute__((address_space(3)))
typedef unsigned short bf16_t;
typedef short bf16x8 __attribute__((ext_vector_type(8)));
typedef float f32x4 __attribute__((ext_vector_type(4)));
typedef unsigned u32x4 __attribute__((ext_vector_type(4)));
constexpr int BM = 256, BK = 64, HALF = 128, HTB = HALF * BK * 2  , STAGE_BYTES = 8 * HTB, NXCD = 8, WGM = 8;

__host__ __device__ __forceinline__ int lds_byte(int r, int c) { const int st = (r >> 4) * 2 + (c >> 5), rr = r & 15, cc = c & 31, ob = rr * 64 + cc * 2; return st * 1024 + (ob ^ (((ob >> 9) & 1) << 5)); }
__host__ __device__ __forceinline__ void stage_rc(int b, int& R, int& C) { const int st = b / 1024, sb = b % 1024, swz = sb ^ (((sb >> 9) & 1) << 5); R = (st >> 1) * 16 + swz / 64; C = (st & 1) * 32 + (swz % 64) / 2; }
__host__ __device__ __forceinline__ int perm32(int rho) { const int n = rho >> 4, i = rho & 15; return 8 * (i >> 2) + 4 * n + (i & 3); }

struct Unit { int pm, pn, g; };
struct Gemm { int lda, ldb, K; };

struct StaticOrder {
    const bf16_t* A; const bf16_t* Bt; size_t ta, tb;
    int nM, nN, nwg, G, c;
    __device__ void init(const bf16_t* A_, const bf16_t* Bt_, int lda, int ldb, int M, int N, int G_, int c_) { A = A_; Bt = Bt_; ta = (size_t)BM * lda * 2; tb = (size_t)BM * ldb * 2; nM = M / BM; nN = N / BM; nwg = nM * nN; G = G_; c = c_; }
    __device__ bool next(int i, Unit& u) const {
        const long L = (long)i * G + c; if (L >= nwg) return false;
        int wgid = (int)L; { const int q = nwg / NXCD, r = nwg % NXCD, xcd = wgid % NXCD, off = wgid / NXCD; wgid = (xcd < r ? xcd * (q + 1) : r * (q + 1) + (xcd - r) * q) + off; }
        const int nig = WGM * nN, gid = wgid / nig, fm = gid * WGM, gsz = (nM - fm) < WGM ? (nM - fm) : WGM;
        u.pm = fm + ((wgid % nig) % gsz); u.pn = (wgid % nig) / gsz; u.g = 0; return true;
    }
    __device__ __forceinline__ const char* a_ptr(const Unit& u) const { return (const char*)A + (size_t)u.pm * ta; }
    __device__ __forceinline__ const char* b_ptr(const Unit& u) const { return (const char*)Bt + (size_t)u.pn * tb; }
    __device__ __forceinline__ void a_ready(const Unit&) const {}
    __device__ __forceinline__ void done(const Unit&) const {}
};

__device__ __forceinline__ unsigned cvt_pk_bf16(float lo, float hi) { unsigned r; asm volatile("v_cvt_pk_bf16_f32 %0, %1, %2" : "=v"(r) : "v"(lo), "v"(hi)); return r; }
__device__ __forceinline__ float bf_lo(unsigned w) { return __uint_as_float(w << 16); }
__device__ __forceinline__ float bf_hi(unsigned w) { return __uint_as_float(w & 0xffff0000u); }
__device__ __forceinline__ float sigmoidf_(float x) { return __builtin_amdgcn_rcpf(1.0f + __builtin_amdgcn_exp2f(-1.4426950408889634f * x)); }
__device__ __forceinline__ float siluf_(float x) { return x * sigmoidf_(x); }
__device__ __forceinline__ float gelu_tanh_(float x) { const float t = 0.7978845608028654f * (x + 0.044715f * x * x * x); return x * sigmoidf_(2.0f * t); }
__device__ __forceinline__ u32x4 pack8f(const f32x4& a, const f32x4& b) { u32x4 w; w.x = cvt_pk_bf16(a[0], a[1]); w.y = cvt_pk_bf16(a[2], a[3]); w.z = cvt_pk_bf16(b[0], b[1]); w.w = cvt_pk_bf16(b[2], b[3]); return w; }

template <class Epi, class Sched, bool ALIGN_EPI = false, bool SP2 = false>
__device__ __forceinline__ void gemm_phase(PG8_LAS unsigned char* lds, const Gemm g, const Sched& S, const Epi& E) {
    const int tid = threadIdx.x, wid = __builtin_amdgcn_readfirstlane(tid >> 6), lane = tid & 63, wr = wid >> 2, wc = wid & 3, fr = lane & 15, fq = lane >> 4;
    const int K = g.K, nt = K / BK;
    unsigned voffA[2], voffB[2];
#pragma unroll
    for (int i = 0; i < 2; ++i) { int R, C; stage_rc(tid * 16 + i * 8192, R, C); const int Rb = Epi::PERM ? ((R & ~31) + perm32(R & 31)) : R;
        voffA[i] = (unsigned)(R * g.lda + C) * 2u; voffB[i] = (unsigned)(Rb * g.ldb + C) * 2u; }
    const size_t kstep = (size_t)(BK * 2);
    const size_t hstepA = (size_t)HALF * g.lda * 2, hstepB = (size_t)HALF * g.ldb * 2;
    const unsigned ldsw = (unsigned)wid * 1024u;
    const int aoff = lds_byte(wr * 64 + fr, fq * 8), boff = lds_byte(wc * 32 + fr, fq * 8);
#define PG8_SA(b, h) (((b) * 2 + (h)) * HTB)
#define PG8_SB(b, h) ((4 + (b) * 2 + (h)) * HTB)
#define PG8_STAGE(bufoff, gbase, voff) do { _Pragma("unroll") for (int _i = 0; _i < 2; ++_i) \
        __builtin_amdgcn_global_load_lds((const unsigned*)((const char*)(gbase) + (voff)[_i]), (PG8_LAS unsigned*)(lds + (bufoff) + ldsw + _i * 8192), 16, 0, 0); } while (0)
#define PG8_LDA(dst, b, h) do { _Pragma("unroll") for (int m = 0; m < 4; ++m) _Pragma("unroll") for (int k = 0; k < 2; ++k) dst[m][k] = *(const PG8_LAS bf16x8*)(lds + PG8_SA(b, h) + aoff + m * 2048 + k * 1024); } while (0)
#define PG8_LDB(dst, b, h) do { _Pragma("unroll") for (int n = 0; n < 2; ++n) _Pragma("unroll") for (int k = 0; k < 2; ++k) dst[n][k] = *(const PG8_LAS bf16x8*)(lds + PG8_SB(b, h) + boff + n * 2048 + k * 1024); } while (0)
#define PG8_MMA(ai, bj, At, Bt) do { __builtin_amdgcn_s_setprio(1); _Pragma("unroll") for (int m = 0; m < 4; ++m) _Pragma("unroll") for (int n = 0; n < 2; ++n) _Pragma("unroll") for (int k = 0; k < 2; ++k) \
        acc[ai][bj][m][n] = __builtin_amdgcn_mfma_f32_16x16x32_bf16(Bt[n][k], At[m][k], acc[ai][bj][m][n], 0, 0, 0); __builtin_amdgcn_s_setprio(0); } while (0)
#define PG8_WAIT_V(n) asm volatile("s_waitcnt vmcnt(" #n ")" ::: "memory")
#define PG8_WAIT_L(n) asm volatile("s_waitcnt lgkmcnt(" #n ")" ::: "memory")
#define PG8_BAR __builtin_amdgcn_s_barrier()
#define PG8_SCHED __builtin_amdgcn_sched_barrier(0)
    Unit cur, nxt; int ui = 0;
    if (!S.next(0, cur)) return;
    f32x4 acc[2][2][4][2];
#pragma unroll
    for (int a = 0; a < 2; ++a)
#pragma unroll
        for (int b = 0; b < 2; ++b)
#pragma unroll
            for (int m = 0; m < 4; ++m)
#pragma unroll
                for (int n = 0; n < 2; ++n) acc[a][b][m][n] = (f32x4){0.f, 0.f, 0.f, 0.f};
    bf16x8 At[4][2], B0[2][2], B1[2][2];
    const char* cA = S.a_ptr(cur); const char* cB = S.b_ptr(cur);
    S.a_ready(cur);
    if constexpr (SP2) {
        PG8_STAGE(PG8_SB(0, 0), cB, voffB); PG8_STAGE(PG8_SB(0, 1), cB + hstepB, voffB); PG8_STAGE(PG8_SA(0, 0), cA, voffA); PG8_STAGE(PG8_SA(0, 1), cA + hstepA, voffA);
        if (wr == 1) PG8_BAR;
        PG8_WAIT_V(2); PG8_BAR;
        PG8_STAGE(PG8_SB(1, 0), cB + kstep, voffB); PG8_STAGE(PG8_SA(1, 0), cA + kstep, voffA); PG8_STAGE(PG8_SB(1, 1), cB + hstepB + kstep, voffB);
        PG8_WAIT_V(6); PG8_BAR;
    } else {
        PG8_STAGE(PG8_SB(0, 0), cB, voffB); PG8_STAGE(PG8_SA(0, 0), cA, voffA); PG8_STAGE(PG8_SB(0, 1), cB + hstepB, voffB); PG8_STAGE(PG8_SA(0, 1), cA + hstepA, voffA);
        if (wr == 1) PG8_BAR;
        PG8_WAIT_V(4); PG8_BAR;
        PG8_STAGE(PG8_SB(1, 0), cB + kstep, voffB); PG8_STAGE(PG8_SA(1, 0), cA + kstep, voffA); PG8_STAGE(PG8_SB(1, 1), cB + hstepB + kstep, voffB);
        PG8_WAIT_V(6); PG8_BAR;
    }
    for (;;) {
        const bool has_next = S.next(ui + 1, nxt);
        const char* nA = has_next ? S.a_ptr(nxt) : cA; const char* nB = has_next ? S.b_ptr(nxt) : cB;
        for (int t = 0; t < nt; t += 2) {
            const bool last = (t == nt - 2);
            const char* a1 = cA + (size_t)(t + 1) * kstep;
            const char* a2 = last ? nA : cA + (size_t)(t + 2) * kstep; const char* b2 = last ? nB : cB + (size_t)(t + 2) * kstep;
            const char* a3 = a2 + kstep; const char* b3 = b2 + kstep;
            if (last && has_next) S.a_ready(nxt);
            if constexpr (SP2) {
            PG8_LDB(B0, 0, 0); PG8_LDB(B1, 0, 1); PG8_SCHED; PG8_LDA(At, 0, 0); PG8_STAGE(PG8_SA(1, 1), a1 + hstepA, voffA);
            PG8_WAIT_V(8); PG8_WAIT_L(0); PG8_BAR; PG8_MMA(0, 0, At, B0); PG8_MMA(0, 1, At, B1); PG8_BAR; PG8_SCHED;
            PG8_LDA(At, 0, 1); PG8_STAGE(PG8_SB(0, 0), b2, voffB); PG8_STAGE(PG8_SB(0, 1), b2 + hstepB, voffB); PG8_STAGE(PG8_SA(0, 0), a2, voffA);
            PG8_WAIT_V(8); PG8_WAIT_L(0); PG8_BAR; PG8_MMA(1, 0, At, B0); PG8_MMA(1, 1, At, B1); PG8_BAR; PG8_SCHED;
            PG8_LDB(B0, 1, 0); PG8_LDB(B1, 1, 1); PG8_SCHED; PG8_LDA(At, 1, 0); PG8_STAGE(PG8_SA(0, 1), a2 + hstepA, voffA);
            PG8_WAIT_V(8); PG8_WAIT_L(0); PG8_BAR; PG8_MMA(0, 0, At, B0); PG8_MMA(0, 1, At, B1); PG8_BAR; PG8_SCHED;
            PG8_LDA(At, 1, 1); PG8_STAGE(PG8_SB(1, 0), b3, voffB); PG8_STAGE(PG8_SB(1, 1), b3 + hstepB, voffB); PG8_STAGE(PG8_SA(1, 0), a3, voffA);
            PG8_WAIT_V(8); PG8_WAIT_L(0); PG8_BAR; PG8_MMA(1, 0, At, B0); PG8_MMA(1, 1, At, B1); PG8_BAR; PG8_SCHED;
            } else {
            PG8_LDB(B0, 0, 0); PG8_SCHED; PG8_LDA(At, 0, 0); PG8_STAGE(PG8_SA(1, 1), a1 + hstepA, voffA);
            PG8_WAIT_L(8); PG8_BAR; PG8_WAIT_L(0); PG8_MMA(0, 0, At, B0); PG8_BAR; PG8_SCHED;
            PG8_LDB(B1, 0, 1); PG8_STAGE(PG8_SB(0, 0), b2, voffB);
            PG8_BAR; PG8_WAIT_L(0); PG8_MMA(0, 1, At, B1); PG8_BAR;
            PG8_LDA(At, 0, 1); PG8_STAGE(PG8_SA(0, 0), a2, voffA);
            PG8_BAR; PG8_WAIT_L(0); PG8_MMA(1, 0, At, B0); PG8_BAR; PG8_SCHED;
            PG8_STAGE(PG8_SB(0, 1), b2 + hstepB, voffB);
            PG8_WAIT_V(6); PG8_BAR; PG8_MMA(1, 1, At, B1); PG8_BAR;
            PG8_LDB(B0, 1, 0); PG8_SCHED; PG8_LDA(At, 1, 0); PG8_STAGE(PG8_SA(0, 1), a2 + hstepA, voffA);
            PG8_WAIT_L(8); PG8_BAR; PG8_WAIT_L(0); PG8_MMA(0, 0, At, B0); PG8_BAR; PG8_SCHED;
            PG8_LDB(B1, 1, 1); PG8_STAGE(PG8_SB(1, 0), b3, voffB);
            PG8_BAR; PG8_WAIT_L(0); PG8_MMA(0, 1, At, B1); PG8_BAR;
            PG8_LDA(At, 1, 1); PG8_STAGE(PG8_SA(1, 0), a3, voffA);
            PG8_BAR; PG8_WAIT_L(0); PG8_MMA(1, 0, At, B0); PG8_BAR; PG8_SCHED;
            PG8_STAGE(PG8_SB(1, 1), b3 + hstepB, voffB);
            PG8_WAIT_V(6); PG8_BAR; PG8_MMA(1, 1, At, B1); PG8_BAR;
            }
        }
        if constexpr (ALIGN_EPI) { if (wr == 0) PG8_BAR; }
        if constexpr (!Epi::AFTER_DRAIN) { E(acc, cur, wr, wc, fr, fq); S.done(cur); }
        if (!has_next) break;
#pragma unroll
        for (int a = 0; a < 2; ++a)
#pragma unroll
            for (int b = 0; b < 2; ++b)
#pragma unroll
                for (int m = 0; m < 4; ++m)
#pragma unroll
                    for (int n = 0; n < 2; ++n) acc[a][b][m][n] = (f32x4){0.f, 0.f, 0.f, 0.f};
        cur = nxt; cA = nA; cB = nB; ++ui;
        if constexpr (ALIGN_EPI) { if (wr == 1) PG8_BAR; }
    }
    PG8_WAIT_V(0);
    if constexpr (!ALIGN_EPI) { if (wr == 0) PG8_BAR; }
    PG8_BAR;
    if constexpr (Epi::AFTER_DRAIN) { E.fused(acc, cur, wr, wc, fr, fq, lds, wid, lane); S.done(cur); }
#undef PG8_SA
#undef PG8_SB
#undef PG8_STAGE
#undef PG8_LDA
#undef PG8_LDB
#undef PG8_MMA
#undef PG8_WAIT_V
#undef PG8_WAIT_L
#undef PG8_BAR
#undef PG8_SCHED
}
}

namespace att {
typedef unsigned short bf16;
typedef short bf16x8 __attribute__((ext_vector_type(8)));
typedef short s16x4 __attribute__((ext_vector_type(4)));
typedef float f32x16 __attribute__((ext_vector_type(16)));
typedef float f32x4 __attribute__((ext_vector_type(4)));
typedef unsigned u32x4 __attribute__((ext_vector_type(4)));
constexpr int D = 128, NW = 8, QBLK = 32, KVBLK = 64, QB = NW * QBLK;
constexpr int QP = 1024, KP = 1024, OP = 2048, GPI = 1024;
constexpr int SHM_V = KVBLK * D * 2, SHM_K = KVBLK * D * 2;
constexpr int LDS_BYTES = 2 * SHM_V + 2 * SHM_K + NW * 64 * 4;
constexpr float SCALE = 0.08838834764831845f, THR = 8.f;
template <class A, class Bt> struct same_t { static constexpr bool v = false; };
template <class A> struct same_t<A, A> { static constexpr bool v = true; };

#define KSWZ(row, colB) ((row) * 256 + ((colB) ^ (((row) & 7) << 4)))
#define SBAR() __builtin_amdgcn_sched_barrier(0)
__device__ __forceinline__ int v_st(int k, int c) { const int kk = (k & ~0xC) | ((k & 4) << 1) | ((k & 8) >> 1); return ((kk >> 3) * 4 + (c >> 5)) * 512 + ((kk & 7) * 32 + (c & 31)) * 2; }
__device__ __forceinline__ int v_rd_base(int lane) { return ((lane & 3) << 3) | (((lane >> 2) & 3) << 6) | (((lane >> 4) & 1) << 5) | (((lane >> 5) & 1) << 8); }
constexpr int v_rd_off(int d0, int ks, int half) { return d0 * 512 + ks * 4096 + half * 2048; }
__device__ __forceinline__ int crow(int r, int hi) { return (r & 3) + 8 * (r >> 2) + 4 * hi; }
__device__ __forceinline__ unsigned cvtpk(float lo, float hi) { unsigned r; asm volatile("v_cvt_pk_bf16_f32 %0, %1, %2" : "=v"(r) : "v"(lo), "v"(hi)); return r; }
__device__ __forceinline__ bf16x8 pack8(f32x4 a, f32x4 b) { u32x4 w = {cvtpk(a[0], a[1]), cvtpk(a[2], a[3]), cvtpk(b[0], b[1]), cvtpk(b[2], b[3])}; return *reinterpret_cast<bf16x8*>(&w); }
__device__ __forceinline__ bf16x8 ld8h(const bf16* p) { return *reinterpret_cast<const bf16x8*>(p); }

__device__ __forceinline__ void mask_tile(f32x16& p0, f32x16& p1, int dq) {
    const float NEG = -__builtin_inff();
#pragma unroll
    for (int r = 0; r < 16; ++r) {
        const int c = (r & 3) + 8 * (r >> 2);
        if (dq - c < 0) p0[r] = NEG;
        if (dq - c - 32 < 0) p1[r] = NEG;
    }
}
__device__ __forceinline__ void partialSM(f32x16& p0, f32x16& p1, float& m_reg, float& mn, float& alpha) {
    float pmax = p0[0]; for (int r = 1; r < 16; ++r) pmax = fmaxf(pmax, p0[r]); for (int r = 0; r < 16; ++r) pmax = fmaxf(pmax, p1[r]);
    { auto rr = __builtin_amdgcn_permlane32_swap(__float_as_uint(pmax), __float_as_uint(pmax), false, false);
      pmax = fmaxf(__uint_as_float(rr[0]), __uint_as_float(rr[1])); }
    constexpr float C2 = 1.4426950408889634f * SCALE;
    if (__builtin_expect(__all((pmax - m_reg) * SCALE <= THR), 1)) { mn = m_reg; alpha = 1.f; }
    else { mn = fmaxf(m_reg, pmax); alpha = __builtin_amdgcn_exp2f((m_reg - mn) * C2); m_reg = mn; }
    const float mnL = -mn * C2;
    for (int r = 0; r < 16; ++r) p0[r] = fmaf(p0[r], C2, mnL); for (int r = 0; r < 16; ++r) p1[r] = fmaf(p1[r], C2, mnL);
    for (int r = 0; r < 16; ++r) p0[r] = __builtin_amdgcn_exp2f(p0[r]);
}
__device__ __forceinline__ void finishSM(f32x16& p0, f32x16& p1, float alpha, float& l_reg, bf16x8& pa0, bf16x8& pa1, bf16x8& pa2, bf16x8& pa3) {
    for (int r = 0; r < 16; ++r) p1[r] = __builtin_amdgcn_exp2f(p1[r]);
    float ps = 0; for (int r = 0; r < 16; ++r) ps += p0[r]; for (int r = 0; r < 16; ++r) ps += p1[r];
    { auto rr = __builtin_amdgcn_permlane32_swap(__float_as_uint(ps), __float_as_uint(ps), false, false);
      ps = __uint_as_float(rr[0]) + __uint_as_float(rr[1]); }
    l_reg = l_reg * alpha + ps;
#define PK4(P, B_, OUT) do { unsigned a0 = cvtpk(P[B_+0], P[B_+1]), a1 = cvtpk(P[B_+2], P[B_+3]);                          \
        unsigned b0 = cvtpk(P[B_+4], P[B_+5]), b1 = cvtpk(P[B_+6], P[B_+7]);                                             \
        auto r0 = __builtin_amdgcn_permlane32_swap(a0, b0, false, false); auto r1 = __builtin_amdgcn_permlane32_swap(a1, b1, false, false); \
        u32x4 w = {r0[0], r1[0], r0[1], r1[1]}; OUT = *reinterpret_cast<bf16x8*>(&w); } while (0)
    PK4(p0, 0, pa0); PK4(p0, 8, pa1); PK4(p1, 0, pa2); PK4(p1, 8, pa3);
#undef PK4
}
__device__ __forceinline__ void loadck(f32x16& p0, f32x16& p1, const float* CK, int off  ) { const float* ckt = CK + off;
#pragma unroll
    for (int g = 0; g < 4; ++g) { const f32x4 a = *(const f32x4*)(ckt + 8 * g), b = *(const f32x4*)(ckt + 32 + 8 * g);
        p0[4 * g] = a[0]; p0[4 * g + 1] = a[1]; p0[4 * g + 2] = a[2]; p0[4 * g + 3] = a[3];
        p1[4 * g] = b[0]; p1[4 * g + 1] = b[1]; p1[4 * g + 2] = b[2]; p1[4 * g + 3] = b[3]; }
}
template <int KB, bool SK>
__device__ __forceinline__ void qkt(f32x16& p0, f32x16& p1, const char* K_lds, int r32, int hi, const bf16x8* qr, float cqv, bool act) {
    if (SK && !act) { const float NEG = -__builtin_inff();
#pragma unroll
        for (int r = 0; r < 16; ++r) { p0[r] = NEG; p1[r] = NEG; } return; }
#pragma unroll
    for (int r = 0; r < 16; ++r) { p0[r] = cqv - p0[r]; p1[r] = cqv - p1[r]; }
    const char* kb[4];
#pragma unroll
    for (int dd = 0; dd < 4; ++dd) kb[dd] = K_lds + KB * SHM_K + KSWZ(r32, (dd * 16 + hi * 8) * 2);
#pragma unroll
    for (int d0 = 0; d0 < 8; ++d0) { const char* a = kb[d0 & 3] + (d0 >> 2) * 128;
        bf16x8 b0 = *reinterpret_cast<const bf16x8*>(a);
        bf16x8 b1 = *reinterpret_cast<const bf16x8*>(a + 32 * 256);
        p0 = __builtin_amdgcn_mfma_f32_32x32x16_bf16(b0, qr[d0], p0, 0, 0, 0);
        p1 = __builtin_amdgcn_mfma_f32_32x32x16_bf16(b1, qr[d0], p1, 0, 0, 0);
        if (d0 == 3) SBAR(); }
}
template <int VB, int ND>
__device__ __forceinline__ void pv_tile(f32x16* o, int vb0, bf16x8 pa0, bf16x8 pa1, bf16x8 pa2, bf16x8 pa3) {
#define TRRD(dst, off) asm volatile("ds_read_b64_tr_b16 %0, %1 offset:%2" : "=&v"(dst) : "v"(vb0), "i"(off) : "memory")
#define PV_D0(d0) do { s16x4 l0, l1, l2, l3, h0, h1, h2, h3; constexpr int b_ = VB * SHM_V + v_rd_off(d0, 0, 0); \
        TRRD(l0, b_); TRRD(h0, b_ + 2048); TRRD(l1, b_ + 4096); TRRD(h1, b_ + 6144); TRRD(l2, b_ + 8192); TRRD(h2, b_ + 10240); TRRD(l3, b_ + 12288); TRRD(h3, b_ + 14336); \
        asm volatile("s_waitcnt lgkmcnt(0)" ::: "memory"); SBAR();   \
        o[d0] = __builtin_amdgcn_mfma_f32_32x32x16_bf16((bf16x8){l0[0], l0[1], l0[2], l0[3], h0[0], h0[1], h0[2], h0[3]}, pa0, o[d0], 0, 0, 0);   \
        o[d0] = __builtin_amdgcn_mfma_f32_32x32x16_bf16((bf16x8){l1[0], l1[1], l1[2], l1[3], h1[0], h1[1], h1[2], h1[3]}, pa1, o[d0], 0, 0, 0);   \
        o[d0] = __builtin_amdgcn_mfma_f32_32x32x16_bf16((bf16x8){l2[0], l2[1], l2[2], l2[3], h2[0], h2[1], h2[2], h2[3]}, pa2, o[d0], 0, 0, 0);   \
        o[d0] = __builtin_amdgcn_mfma_f32_32x32x16_bf16((bf16x8){l3[0], l3[1], l3[2], l3[3], h3[0], h3[1], h3[2], h3[3]}, pa3, o[d0], 0, 0, 0); } while (0)
    PV_D0(0); if constexpr (ND == 4) { PV_D0(1); PV_D0(2); PV_D0(3); }
#undef PV_D0
#undef TRRD
}

template <class TKV> struct BlockRef { const bf16* Q; const TKV* K; const TKV* V; const TKV* Kn; const TKV* Vn; bf16* O; const bf16* G; const float* CQ; const float* CK; int np, P0, jhi; };
struct Seam { bf16x8 qr[8]; bf16x8 st_v0, st_v1, st_k0, st_k1; f32x4 sf0, sf1, sf2, sf3; };

#define TBASE(ref, base, basen, k0, half) ((F32 && (k0) >= (ref).np) ? (const char*)(basen) : (const char*)((base) + (size_t)((k0) + 32 * (half)) * KP))
#define VMW() asm volatile("s_waitcnt vmcnt(0)" ::: "memory")
#define VMWN(n) asm volatile("s_waitcnt vmcnt(%0)" :: "i"(n) : "memory")
#define SLOAD_H(ref, k0) do { S.st_v0 = *(const bf16x8*)(TBASE(ref, (ref).V, (ref).Vn, k0, 0) + rofs); S.st_v1 = *(const bf16x8*)(TBASE(ref, (ref).V, (ref).Vn, k0, 1) + rofs);              \
                              S.st_k0 = *(const bf16x8*)(TBASE(ref, (ref).K, (ref).Kn, k0, 0) + rofs); S.st_k1 = *(const bf16x8*)(TBASE(ref, (ref).K, (ref).Kn, k0, 1) + rofs); } while (0)
#define SWRITE_HK(bf) do { *(bf16x8*)(K_lds + (bf) * SHM_K + kws) = S.st_k0; *(bf16x8*)(K_lds + (bf) * SHM_K + kws + 32 * 256) = S.st_k1; } while (0)
#define SWRITE_HV(bf) do { *(bf16x8*)(V_lds + (bf) * SHM_V + vst0) = S.st_v0; *(bf16x8*)(V_lds + (bf) * SHM_V + vst0 + 8192) = S.st_v1; } while (0)
#define SWRITE_H(bf) do { SWRITE_HV(bf); SWRITE_HK(bf); } while (0)
#define SLOAD_FK(ref, k0) do { const char* r0_ = TBASE(ref, (ref).K, (ref).Kn, k0, 0) + rofs; const char* r1_ = TBASE(ref, (ref).K, (ref).Kn, k0, 1) + rofs; \
                               S.sf0 = *(const f32x4*)r0_; S.sf1 = *(const f32x4*)(r0_ + 16); S.sf2 = *(const f32x4*)r1_; S.sf3 = *(const f32x4*)(r1_ + 16); } while (0)
#define SLOAD_FV(ref, k0) do { const char* r0_ = TBASE(ref, (ref).V, (ref).Vn, k0, 0) + rofs; const char* r1_ = TBASE(ref, (ref).V, (ref).Vn, k0, 1) + rofs; \
                               S.sf0 = *(const f32x4*)r0_; S.sf1 = *(const f32x4*)(r0_ + 16); S.sf2 = *(const f32x4*)r1_; S.sf3 = *(const f32x4*)(r1_ + 16); } while (0)
#define SWRITE_KF(bf) do { *(bf16x8*)(K_lds + (bf) * SHM_K + kws) = pack8(S.sf0, S.sf1); *(bf16x8*)(K_lds + (bf) * SHM_K + kws + 32 * 256) = pack8(S.sf2, S.sf3); } while (0)
#define SWRITE_VF(bf) do { *(bf16x8*)(V_lds + (bf) * SHM_V + vst0) = pack8(S.sf0, S.sf1); *(bf16x8*)(V_lds + (bf) * SHM_V + vst0 + 8192) = pack8(S.sf2, S.sf3); } while (0)

template <class TKV, bool SOLO>
__device__ __forceinline__ void fox_prime(const BlockRef<TKV>& cur, char* lds, Seam& S) {
    constexpr bool F32 = same_t<TKV, float>::v;
    const int tid = threadIdx.x, wid = __builtin_amdgcn_readfirstlane(tid >> 6), lane = tid & 63, r32 = lane & 31, hi = lane >> 5;
    const int wq = SOLO ? 0 : wid;
    const int sr = tid >> 4, sc = (tid & 15) * 8, kws = KSWZ(sr, sc * 2); char* K_lds = lds + 2 * SHM_V;
    const unsigned rofs = (unsigned)(sr * KP + sc) * (unsigned)sizeof(TKV);
    constexpr int kb0 = 0;
#pragma unroll
    for (int d0 = 0; d0 < 8; ++d0) S.qr[d0] = ld8h(cur.Q + (size_t)(wq * QBLK + r32) * QP + d0 * 16 + hi * 8);
    if constexpr (F32) { SLOAD_FK(cur, kb0); VMW(); SWRITE_KF(0); SBAR(); SLOAD_FV(cur, kb0); }
    else { SLOAD_H(cur, kb0); VMW(); SWRITE_HK(0); }
    __syncthreads();
}
template <class TKV, bool SOLO>
__device__ __forceinline__ void fox_block(const BlockRef<TKV>& cur, const BlockRef<TKV>& nxt, char* lds, Seam& S) {
    constexpr bool F32 = same_t<TKV, float>::v;
    constexpr bool SK = false;
    const int tid = threadIdx.x, wid = __builtin_amdgcn_readfirstlane(tid >> 6), lane = tid & 63, r32 = lane & 31, hi = lane >> 5;
    const int wq = SOLO ? 0 : wid;
    constexpr bool wact = true;
    constexpr int j_lo = 0, kbn = 0;
    const int NT = cur.jhi;
    const int qlo = cur.P0 + wq * QBLK, qm = qlo + r32 - 4 * hi;
    char* V_lds = lds; char* K_lds = lds + 2 * SHM_V;
    constexpr int ND = SOLO ? 1 : 4;
    float m_reg = -1e30f, l_reg = 0; f32x16 o[ND] = {};
    const int sr = tid >> 4, sc = (tid & 15) * 8, vst0 = v_st(sr, sc), kws = KSWZ(sr, sc * 2);
    const unsigned rofs = (unsigned)(sr * KP + sc) * (unsigned)sizeof(TKV);
    const int vb0 = (int)(uintptr_t)V_lds + v_rd_base(lane) + (SOLO ? (wid & 3) * 512 : 0);
    const float cqv = cur.CQ[wq * QBLK + r32];
#define RESC(a) do { if (__any((a) < 1.f)) { for (int d_ = 0; d_ < ND; ++d_) for (int r = 0; r < 16; ++r) o[d_][r] *= (a); } } while (0)
#define KBASE(t) ((j_lo + (t)) * KVBLK)
#define MASKT(P0_, P1_, t) do { const int kb_ = KBASE(t); if (wact && kb_ + KVBLK - 1 > qlo) mask_tile(P0_, P1_, qm - kb_); } while (0)
#define LOADCK(P0_, P1_, t) do { if (wact) loadck(P0_, P1_, cur.CK, KBASE(t) + 4 * hi); } while (0)
    constexpr int NQL = 8;
#define SEAM_K0() do { VMWN(NQL); if constexpr (F32) { SWRITE_KF(0); SBAR(); SLOAD_FV(nxt, kbn); } else { SWRITE_HK(0); } SBAR(); } while (0)
    f32x16 pA0, pA1, pB0, pB1; float mnA, mnB, alA, alB; bf16x8 pa0, pa1, pa2, pa3;
    LOADCK(pA0, pA1, 0);
    if constexpr (F32) { VMW(); SWRITE_VF(0); SBAR(); } else { SWRITE_HV(0); SBAR(); }
    if (NT > 1) { if constexpr (F32) SLOAD_FK(cur, KBASE(1)); else SLOAD_H(cur, KBASE(1)); }
    SBAR(); qkt<0, SK>(pA0, pA1, K_lds, r32, hi, S.qr, cqv, wact);
    if (NT > 1) { LOADCK(pB0, pB1, 1); SBAR(); }
    if constexpr (F32) { if (NT > 1) { VMW(); SWRITE_KF(1); SBAR(); SLOAD_FV(cur, KBASE(1)); } }
    MASKT(pA0, pA1, 0); partialSM(pA0, pA1, m_reg, mnA, alA);
    if (NT > 1) { VMW(); if constexpr (F32) { SWRITE_VF(1); SBAR(); if (NT > 2) SLOAD_FK(cur, KBASE(2)); } else SWRITE_H(1); }
    __syncthreads();
#define HALF_STEP(PX0, PX1, mnX, alX, PY0, PY1, alY, t, KB, VB, SB) do {                                                      \
        SBAR(); qkt<KB, SK>(PX0, PX1, K_lds, r32, hi, S.qr, cqv, wact);                                                       \
        finishSM(PY0, PY1, alY, l_reg, pa0, pa1, pa2, pa3); SBAR();                                                           \
        if ((t) + 1 < NT) { if constexpr (F32) { VMW(); SWRITE_KF(SB); SBAR(); SLOAD_FV(cur, KBASE((t) + 1)); }               \
                            else { SLOAD_H(cur, KBASE((t) + 1)); } SBAR(); LOADCK(PY0, PY1, (t) + 1); SBAR(); }               \
        pv_tile<VB, ND>(o, vb0, pa0, pa1, pa2, pa3); MASKT(PX0, PX1, (t)); partialSM(PX0, PX1, m_reg, mnX, alX);        \
        __syncthreads();                                                                                                      \
        if ((t) + 1 < NT) { VMW(); if constexpr (F32) { SWRITE_VF(SB); SBAR(); if ((t) + 2 < NT) SLOAD_FK(cur, KBASE((t) + 2)); } \
                            else { SWRITE_H(SB); } }                                                                          \
        RESC(alX); __syncthreads(); } while (0)
    for (int t = 1; t + 1 < NT; t += 2) {
        HALF_STEP(pB0, pB1, mnB, alB, pA0, pA1, alA, t, 1, 0, 0);
        HALF_STEP(pA0, pA1, mnA, alA, pB0, pB1, alB, t + 1, 0, 1, 1);
    }
    const bool even = (NT & 1) == 0;
    if (even) { SBAR(); qkt<1, SK>(pB0, pB1, K_lds, r32, hi, S.qr, cqv, wact); SBAR(); }
    if constexpr (F32) { SLOAD_FK(nxt, kbn); SBAR(); } else { SLOAD_H(nxt, kbn); SBAR(); }
    { const int wqn = SOLO ? 0 : wid;
#pragma unroll
      for (int d0 = 0; d0 < 8; ++d0) S.qr[d0] = ld8h(nxt.Q + (size_t)(wqn * QBLK + r32) * QP + d0 * 16 + hi * 8); }
    SBAR();
    finishSM(pA0, pA1, alA, l_reg, pa0, pa1, pa2, pa3); SBAR();
    pv_tile<0, ND>(o, vb0, pa0, pa1, pa2, pa3);
    if (even) { MASKT(pB0, pB1, NT - 1); partialSM(pB0, pB1, m_reg, mnB, alB); __syncthreads(); RESC(alB);
        finishSM(pB0, pB1, alB, l_reg, pa0, pa1, pa2, pa3); SBAR(); pv_tile<1, ND>(o, vb0, pa0, pa1, pa2, pa3); }
    SBAR(); SEAM_K0();
    if (!SOLO || wid < 4) {
        const float inv = __builtin_amdgcn_rcpf(l_reg);
        const int cb = SOLO ? (wid & 3) * 32 : 0;
        bf16* Ow = cur.O + (size_t)(wq * QBLK + r32) * OP + 4 * hi + cb; const bf16* Gw = cur.G + (size_t)(wq * QBLK + r32) * GPI + 4 * hi + cb;
#pragma unroll
        for (int d0 = 0; d0 < ND; ++d0) {
#pragma unroll
            for (int g = 0; g < 4; ++g) { const uint2 gt = *(const uint2*)(Gw + d0 * 32 + 8 * g);
                uint2 w; w.x = cvtpk(o[d0][4 * g] * inv * __uint_as_float(gt.x << 16), o[d0][4 * g + 1] * inv * __uint_as_float(gt.x & 0xffff0000u));
                w.y = cvtpk(o[d0][4 * g + 2] * inv * __uint_as_float(gt.y << 16), o[d0][4 * g + 3] * inv * __uint_as_float(gt.y & 0xffff0000u));
                *(uint2*)(Ow + d0 * 32 + 8 * g) = w; }
            asm volatile("" ::: "memory"); }
    }
    __syncthreads();
#undef RESC
#undef KBASE
#undef MASKT
#undef LOADCK
#undef SEAM_K0
#undef HALF_STEP
}
#undef TBASE
#undef VMW
#undef VMWN
#undef SLOAD_H
#undef SWRITE_HK
#undef SWRITE_HV
#undef SWRITE_H
#undef SLOAD_FK
#undef SLOAD_FV
#undef SWRITE_KF
#undef SWRITE_VF
}

constexpr int DM = 2048, NB = 4, SEQ = 8192, DECB = 32, DECS = 32, PAST = 4096, NH = 8, HD = 128, DATT = 1024, DSSM = 1024, NG = 64, NST = 64, DPLE = 256;
constexpr int MP = NB * SEQ, MS = DECB * DECS, MT = MP + MS;
constexpr int DIN = 6152, OFF_F = 3072;
constexpr int NIN = 6144;
constexpr int CHUNK = 32, NCH = MT / CHUNK, UHROWS = NCH, UHLD = 640;
constexpr int NSSM_ITEMS = NG * 5;
constexpr int CSLD = 4160;
constexpr float EPS = 1e-6f;
constexpr size_t O_YP = 0, O_YS = O_YP + (size_t)MP * DM, O_KP = O_YS + (size_t)MS * DM, O_VP = O_KP + (size_t)MP * DATT, O_LFP = O_VP + (size_t)MP * DATT,
                 O_SRP = O_LFP + (size_t)MP * NH, O_SIP = O_SRP + NB * NG * NST, O_KS = O_SIP + NB * NG * NST, O_VS = O_KS + (size_t)MS * DATT, O_LFS = O_VS + (size_t)MS * DATT,
                 O_SRS = O_LFS + (size_t)MS * NH, O_SIS = O_SRS + DECB * NG * NST, O_END = O_SIS + DECB * NG * NST;
constexpr size_t MiB = 1u << 20;
constexpr size_t WS_CTL = 0, CTL_ZERO_BYTES = 1 * MiB;
constexpr size_t WS_WIN_T = 1 * MiB, WS_WGLU_T = 25 * MiB, WS_WOUT_T = 27 * MiB, WS_WPE_T = 35 * MiB, WS_WPG_T = 36 * MiB;
constexpr size_t WS_MW_T = 44 * MiB, WS_BP_T = 84 * MiB, WS_A32 = 100 * MiB, WS_LOGF = 101 * MiB, WS_CP = 103 * MiB, WS_CS = 104 * MiB;
constexpr size_t WS_ESS = 109 * MiB, WS_H2SS = 114 * MiB, WS_RSTDE = 119 * MiB;
constexpr size_t WS_XN = 120 * MiB, WS_PB = 252 * MiB, WS_Q = 270 * MiB, WS_K = 336 * MiB, WS_V = 402 * MiB, WS_SGA = 468 * MiB, WS_SGS = 534 * MiB;
constexpr size_t WS_UH = 600 * MiB, WS_SBUF = 684 * MiB, WS_YACT = 724 * MiB, WS_MIXED = 790 * MiB, WS_HB = 922 * MiB, WS_E = 1054 * MiB, WS_QSS = 1186 * MiB, WS_KSS = 1191 * MiB, WS_END = 1196 * MiB;
constexpr size_t WS_GP = 1200 * MiB;
static_assert(WS_LOGF + (size_t)MT * 8 * 4 <= WS_CP && WS_CS + (size_t)DECB * NH * CSLD * 4 <= WS_ESS && WS_ESS + (size_t)MT * 32 * 4 <= WS_H2SS && WS_H2SS + (size_t)MT * 32 * 4 <= WS_RSTDE, "ws map a");
static_assert(WS_XN + (size_t)MT * DM * 2 <= WS_PB && WS_PB + (size_t)MT * DPLE * 2 <= WS_Q && WS_Q + (size_t)MT * DATT * 2 <= WS_K && WS_UH + (size_t)(NG * UHROWS + 256) * UHLD * 2 <= WS_SBUF, "ws map b");
static_assert(WS_SBUF + (size_t)NSSM_ITEMS * 256 * 128 * 4 <= WS_YACT && WS_YACT + (size_t)MT * DSSM * 2 <= WS_MIXED && WS_MIXED + (size_t)MT * DM * 2 <= WS_HB && WS_E + (size_t)MT * DM * 2 <= WS_QSS && WS_QSS + (size_t)MT * 32 * 4 <= WS_KSS && WS_KSS + (size_t)MT * 32 * 4 <= WS_END, "ws map c");
constexpr int CW_TMO = 0, CW_BAR = 4096;

constexpr int NWAVES = 8, NTHR = 512;
constexpr int RING_OFF = 0, RING_BYTES = 131072, LDSCTL_OFF = RING_BYTES, MISC_OFF = LDSCTL_OFF + 320, LDS_BYTES = 147456;

#define GAS __attribute__((address_space(1)))
#define LAS __attribute__((address_space(3)))
typedef unsigned short bf16;
typedef unsigned v4u __attribute__((ext_vector_type(4)));
typedef unsigned v2u __attribute__((ext_vector_type(2)));
typedef float f32x4 __attribute__((ext_vector_type(4)));
typedef float f32x2 __attribute__((ext_vector_type(2)));
#define LDS_WAIT() asm volatile("s_waitcnt lgkmcnt(0)" ::: "memory")
#define VM_WAIT() asm volatile("s_waitcnt vmcnt(0)" ::: "memory")
__device__ __forceinline__ unsigned f2bf(float f) { unsigned u = __builtin_bit_cast(unsigned, f); return (u + 0x7fffu + ((u >> 16) & 1u)) >> 16; }
__device__ __forceinline__ unsigned pk2(float lo, float hi) { return f2bf(lo) | (f2bf(hi) << 16); }
__device__ __forceinline__ float wave_sum(float v) {
#pragma unroll
    for (int o = 1; o < 64; o <<= 1) v += __shfl_xor(v, o);
    return v;
}

#define XB_TMO      128
#define XB_XCNT(j)  (256  + 64 * (j))
#define XB_XSUB(j)  (1280 + 64 * (j))
#define XB_XGEN(j)  (2304 + 64 * (j))
#define XB_TOP      3328
#define XB_TOPGEN   3392
#define XCD_BAR_WORDS 3456
#define XB_SPIN_CAP (1u << 22)
__device__ __forceinline__ unsigned xb_ld(unsigned* p)              { return __hip_atomic_load(p, __ATOMIC_RELAXED, __HIP_MEMORY_SCOPE_AGENT); }
__device__ __forceinline__ unsigned xb_add(unsigned* p, unsigned v) { return __hip_atomic_fetch_add(p, v, __ATOMIC_RELAXED, __HIP_MEMORY_SCOPE_AGENT); }
__device__ __forceinline__ unsigned xb_xcc_id() { return (unsigned)__builtin_amdgcn_s_getreg((3 << 11) | 20) & 0xFu; }
#define XB_SPIN(cond, bar) do { unsigned _sp = 0; while (cond) { __builtin_amdgcn_s_sleep(1); \
    if ((++_sp & 255u) == 0u) { if (xb_ld(&(bar)[XB_TMO])) break; if (_sp > XB_SPIN_CAP) { atomicAdd(&(bar)[XB_TMO], 1u); break; } } } } while (0)
struct XcdBarrier { unsigned* bar; unsigned x; volatile LAS unsigned* st; };
__device__ __forceinline__ XcdBarrier xcd_barrier_post(unsigned* bar, volatile LAS unsigned* st) {
    XcdBarrier b; b.bar = bar; b.x = xb_xcc_id(); b.st = st;
    if (threadIdx.x == 0) (void)xb_add(&bar[XB_XCNT(b.x)], 1u);
    return b;
}
__device__ __forceinline__ void xcd_barrier_complete(unsigned* bar, unsigned x, unsigned& nloc, unsigned& nx) {
    const unsigned G = gridDim.x * gridDim.y * gridDim.z;
    unsigned sum, cnt, mine, sp = 0u;
    for (;;) {
        sum = 0u; cnt = 0u; mine = 0u;
#pragma unroll
        for (unsigned j = 0; j < 16; ++j) { const unsigned c = xb_ld(&bar[XB_XCNT(j)]); sum += c; cnt += (c > 0u) ? 1u : 0u; mine = (j == x) ? c : mine; }
        if (sum == G) break;
        __builtin_amdgcn_s_sleep(1);
        if ((++sp & 255u) == 0u) { if (xb_ld(&bar[XB_TMO])) break; if (sp > XB_SPIN_CAP) { atomicAdd(&bar[XB_TMO], 1u); break; } }
    }
    nloc = mine > 0u ? mine : 1u; nx = cnt > 0u ? cnt : 1u;
}
__device__ __forceinline__ void xcd_barrier(const XcdBarrier& b) {
    asm volatile("s_waitcnt vmcnt(0)" ::: "memory");
    __syncthreads();
    if (threadIdx.x == 0) {
        unsigned* bar = b.bar;
        __builtin_amdgcn_s_waitcnt(0);
        unsigned nloc = b.st[0], nx = b.st[1];
        if (nloc == 0u) { xcd_barrier_complete(bar, b.x, nloc, nx); b.st[0] = nloc; b.st[1] = nx; }
        const unsigned old = xb_add(&bar[XB_XSUB(b.x)], 1u);
        const unsigned gen = old / nloc;
        if (old + 1u == (gen + 1u) * nloc) {
            __builtin_amdgcn_fence(__ATOMIC_RELEASE, "agent");
            asm volatile("s_waitcnt vmcnt(0)" ::: "memory");
            const unsigned og = xb_add(&bar[XB_TOP], 1u);
            const unsigned tg = og / nx;
            if (og + 1u == (tg + 1u) * nx) xb_add(&bar[XB_TOPGEN], 1u);
            else XB_SPIN(xb_ld(&bar[XB_TOPGEN]) == tg, bar);
            __builtin_amdgcn_fence(__ATOMIC_ACQUIRE, "agent");
            xb_add(&bar[XB_XGEN(b.x)], 1u);
            asm volatile("s_waitcnt vmcnt(0)" ::: "memory");
        } else {
            XB_SPIN(xb_ld(&bar[XB_XGEN(b.x)]) == gen, bar);
            __builtin_amdgcn_fence(__ATOMIC_ACQUIRE, "agent");
            asm volatile("s_waitcnt vmcnt(0)" ::: "memory");
        }
    }
    __syncthreads();
}

enum { I_XP = 0, I_XS, I_PP, I_PS, I_CK, I_CV, I_CLF, I_SRE, I_SIM, I_GIN, I_WIN, I_BF, I_ARE, I_AIM, I_LDT, I_BRE, I_BIM, I_CRE, I_CIM, I_DSK, I_WGLU, I_WOUT, I_WPE, I_GPE, I_WPG, I_GFIN, N_IN };
struct Args { const float* in[N_IN]; float* out; unsigned char* ws; int ph_lo, ph_hi; };
typedef const __attribute__((address_space(4))) Args* KArgs;
__device__ __forceinline__ KArgs launder_kernarg() { KArgs p = (KArgs)__builtin_amdgcn_kernarg_segment_ptr(); asm volatile("" : "+s"(p)); return p; }

using pg8::Unit; using pg8::BM; using pg8::HALF; using pg8::cvt_pk_bf16; using pg8::pack8f; using pg8::bf_lo; using pg8::bf_hi; using pg8::sigmoidf_; using pg8::siluf_; using pg8::gelu_tanh_;
#define EPI_ARGS const f32x4 (&acc)[2][2][4][2], const Unit& u, int wr, int wc, int fr, int fq
struct EpiInProj { static constexpr bool PERM = true, AFTER_DRAIN = false;
    bf16 *Q, *K, *V, *SGA, *SGS, *UH; float *kp, *vp, *ks, *vs; float *QSS, *KSS;
    __device__ __forceinline__ void operator()(EPI_ARGS) const {
        const int seg = u.pn >> 2, csb = (u.pn & 3) * 256 + wc * 32 + 8 * fq, row0 = u.pm * BM + wr * 64 + fr;
        if (seg == 0 || seg == 3 || seg == 5) {
            bf16* dst = seg == 0 ? Q : (seg == 3 ? SGA : SGS);
#pragma unroll
            for (int ai = 0; ai < 2; ++ai)
#pragma unroll
                for (int m = 0; m < 4; ++m) { bf16* rowp = dst + (size_t)(row0 + ai * HALF + m * 16) * 1024 + csb;
#pragma unroll
                    for (int bj = 0; bj < 2; ++bj) { f32x4 v0 = acc[ai][bj][m][0], v1 = acc[ai][bj][m][1];
                        if (seg != 0) { for (int i = 0; i < 4; ++i) { v0[i] = siluf_(v0[i]); v1[i] = siluf_(v1[i]); } }
                        else { float ss = (v0[0] * v0[0] + v0[1] * v0[1]) + (v0[2] * v0[2] + v0[3] * v0[3]) + (v1[0] * v1[0] + v1[1] * v1[1]) + (v1[2] * v1[2] + v1[3] * v1[3]);
                            ss += __shfl_xor(ss, 16); ss += __shfl_xor(ss, 32);
                            if (fq == 0) QSS[((size_t)(row0 + ai * HALF + m * 16) * 8 + (u.pn & 3) * 2 + bj) * 4 + wc] = ss; }
                        *(v4u*)(rowp + bj * HALF) = pack8f(v0, v1); } }
        } else if (seg == 1 || seg == 2) {
            bf16* dst = seg == 1 ? K : V; float* o32 = u.pm < MP / BM ? (seg == 1 ? kp : vp) : (seg == 1 ? ks : vs) - (size_t)MP * 1024;
#pragma unroll
            for (int ai = 0; ai < 2; ++ai)
#pragma unroll
                for (int m = 0; m < 4; ++m) { const size_t ro = (size_t)(row0 + ai * HALF + m * 16) * 1024 + csb;
#pragma unroll
                    for (int bj = 0; bj < 2; ++bj) { const f32x4 v0 = acc[ai][bj][m][0], v1 = acc[ai][bj][m][1];
                        if (seg == 1) { float ss = (v0[0] * v0[0] + v0[1] * v0[1]) + (v0[2] * v0[2] + v0[3] * v0[3]) + (v1[0] * v1[0] + v1[1] * v1[1]) + (v1[2] * v1[2] + v1[3] * v1[3]);
                            ss += __shfl_xor(ss, 16); ss += __shfl_xor(ss, 32);
                            if (fq == 0) KSS[((size_t)(row0 + ai * HALF + m * 16) * 8 + (u.pn & 3) * 2 + bj) * 4 + wc] = ss; }
                        *(v4u*)(dst + ro + bj * HALF) = pack8f(v0, v1); *(f32x4*)(o32 + ro + bj * HALF) = v0; *(f32x4*)(o32 + ro + bj * HALF + 4) = v1; } }
        } else {
#pragma unroll
            for (int ai = 0; ai < 2; ++ai)
#pragma unroll
                for (int m = 0; m < 4; ++m) { const int row = row0 + ai * HALF + m * 16, chunk = row >> 5, s = row & 31;
#pragma unroll
                    for (int bj = 0; bj < 2; ++bj) { const int cs = csb + bj * HALF, g = cs >> 4, c0 = cs & 15;
                        *(v4u*)(UH + ((size_t)g * UHROWS + chunk) * UHLD + s * 16 + c0) = pack8f(acc[ai][bj][m][0], acc[ai][bj][m][1]); } }
        }
    }
};
struct EpiPle { static constexpr bool PERM = true, AFTER_DRAIN = false;
    bf16* E; float* ESS;
    __device__ __forceinline__ void operator()(EPI_ARGS) const {
        const int col0 = u.pn * BM + wc * 32 + 8 * fq, row0 = u.pm * BM + wr * 64 + fr;
#pragma unroll
        for (int ai = 0; ai < 2; ++ai)
#pragma unroll
            for (int m = 0; m < 4; ++m) { const int row = row0 + ai * HALF + m * 16; float ss = 0.f;
#pragma unroll
                for (int bj = 0; bj < 2; ++bj) { const f32x4 v0 = acc[ai][bj][m][0], v1 = acc[ai][bj][m][1];
                    ss += (v0[0] * v0[0] + v0[1] * v0[1]) + (v0[2] * v0[2] + v0[3] * v0[3]) + (v1[0] * v1[0] + v1[1] * v1[1]) + (v1[2] * v1[2] + v1[3] * v1[3]);
                    *(v4u*)(E + (size_t)row * DM + col0 + bj * HALF) = pack8f(v0, v1); }
                ss += __shfl_xor(ss, 16); ss += __shfl_xor(ss, 32);
                if (fq == 0) ESS[(size_t)row * 32 + u.pn * 4 + wc] = ss; }
    }
};
struct EpiGlu { static constexpr bool PERM = true, AFTER_DRAIN = false;
    const bf16 *YACT, *SGS; bf16* MIXED;
    __device__ __forceinline__ void operator()(EPI_ARGS) const {
        const int col0 = u.pn * BM + wc * 32 + 8 * fq, row0 = u.pm * BM + wr * 64 + fr;
#pragma unroll
        for (int ai = 0; ai < 2; ++ai)
#pragma unroll
            for (int m = 0; m < 4; ++m) { const int row = row0 + ai * HALF + m * 16;
#pragma unroll
                for (int bj = 0; bj < 2; ++bj) { const size_t o = (size_t)row * 1024 + col0 + bj * HALF;
                    const v4u ya = *(const v4u*)(YACT + o), sg = *(const v4u*)(SGS + o); f32x4 v0 = acc[ai][bj][m][0], v1 = acc[ai][bj][m][1];
                    v0[0] = bf_lo(ya.x) * sigmoidf_(v0[0]) * bf_lo(sg.x); v0[1] = bf_hi(ya.x) * sigmoidf_(v0[1]) * bf_hi(sg.x);
                    v0[2] = bf_lo(ya.y) * sigmoidf_(v0[2]) * bf_lo(sg.y); v0[3] = bf_hi(ya.y) * sigmoidf_(v0[3]) * bf_hi(sg.y);
                    v1[0] = bf_lo(ya.z) * sigmoidf_(v1[0]) * bf_lo(sg.z); v1[1] = bf_hi(ya.z) * sigmoidf_(v1[1]) * bf_hi(sg.z);
                    v1[2] = bf_lo(ya.w) * sigmoidf_(v1[2]) * bf_lo(sg.w); v1[3] = bf_hi(ya.w) * sigmoidf_(v1[3]) * bf_hi(sg.w);
                    *(v4u*)(MIXED + (size_t)row * DM + 1024 + col0 + bj * HALF) = pack8f(v0, v1); } }
    }
};
struct EpiOut { static constexpr bool PERM = true, AFTER_DRAIN = false;
    const float *xp, *xs; bf16* HB;
    __device__ __forceinline__ void operator()(EPI_ARGS) const {
        const int col0 = u.pn * BM + wc * 32 + 8 * fq, row0 = u.pm * BM + wr * 64 + fr;
        const float* xb = u.pm < MP / BM ? xp : xs - (size_t)MP * DM;
#pragma unroll
        for (int ai = 0; ai < 2; ++ai)
#pragma unroll
            for (int m = 0; m < 4; ++m) { const int row = row0 + ai * HALF + m * 16;
#pragma unroll
                for (int bj = 0; bj < 2; ++bj) { const size_t o = (size_t)row * DM + col0 + bj * HALF;
                    const f32x4 v0 = acc[ai][bj][m][0] + *(const f32x4*)(xb + o), v1 = acc[ai][bj][m][1] + *(const f32x4*)(xb + o + 4);
                    *(v4u*)(HB + o) = pack8f(v0, v1); } }
    }
};
struct EpiPg { static constexpr bool PERM = true, AFTER_DRAIN = false;
    const bf16* HB; bf16* H2B; const bf16* E; const float *RSTDE, *gpe; float* H2SS;
    __device__ __forceinline__ void operator()(EPI_ARGS) const {
        const int col0 = u.pn * BM + wc * 32 + 8 * fq, row0 = u.pm * BM + wr * 64 + fr;
        f32x4 gp[2][2];
#pragma unroll
        for (int bj = 0; bj < 2; ++bj) { gp[bj][0] = *(const f32x4*)(gpe + col0 + bj * HALF); gp[bj][1] = *(const f32x4*)(gpe + col0 + bj * HALF + 4); }
#pragma unroll
        for (int ai = 0; ai < 2; ++ai)
#pragma unroll
            for (int m = 0; m < 4; ++m) { const int row = row0 + ai * HALF + m * 16; const float rs = RSTDE[row]; float ss = 0.f;
#pragma unroll
                for (int bj = 0; bj < 2; ++bj) { const size_t o = (size_t)row * DM + col0 + bj * HALF;
                    const v4u e = *(const v4u*)(E + o), hh = *(const v4u*)(HB + o); const f32x4 a0 = acc[ai][bj][m][0], a1 = acc[ai][bj][m][1];
                    f32x4 v0, v1;
                    v0[0] = bf_lo(hh.x) + bf_lo(e.x) * rs * gp[bj][0][0] * sigmoidf_(a0[0]); v0[1] = bf_hi(hh.x) + bf_hi(e.x) * rs * gp[bj][0][1] * sigmoidf_(a0[1]);
                    v0[2] = bf_lo(hh.y) + bf_lo(e.y) * rs * gp[bj][0][2] * sigmoidf_(a0[2]); v0[3] = bf_hi(hh.y) + bf_hi(e.y) * rs * gp[bj][0][3] * sigmoidf_(a0[3]);
                    v1[0] = bf_lo(hh.z) + bf_lo(e.z) * rs * gp[bj][1][0] * sigmoidf_(a1[0]); v1[1] = bf_hi(hh.z) + bf_hi(e.z) * rs * gp[bj][1][1] * sigmoidf_(a1[1]);
                    v1[2] = bf_lo(hh.w) + bf_lo(e.w) * rs * gp[bj][1][2] * sigmoidf_(a1[2]); v1[3] = bf_hi(hh.w) + bf_hi(e.w) * rs * gp[bj][1][3] * sigmoidf_(a1[3]);
                    ss += (v0[0] * v0[0] + v0[1] * v0[1]) + (v0[2] * v0[2] + v0[3] * v0[3]) + (v1[0] * v1[0] + v1[1] * v1[1]) + (v1[2] * v1[2] + v1[3] * v1[3]);
                    *(v4u*)(H2B + o) = pack8f(v0, v1); }
                ss += __shfl_xor(ss, 16); ss += __shfl_xor(ss, 32);
                if (fq == 0) H2SS[(size_t)row * 32 + u.pn * 4 + wc] = ss; }
    }
};
struct EpiSsmS { static constexpr bool PERM = false, AFTER_DRAIN = false;
    float* SBUF;
    __device__ __forceinline__ void operator()(EPI_ARGS) const {
        float* base = SBUF + (size_t)(u.g * 5 + u.pm) * 256 * 128; const int col0 = wc * 32 + 4 * fq, row0 = wr * 64 + fr;
#pragma unroll
        for (int ai = 0; ai < 2; ++ai)
#pragma unroll
            for (int m = 0; m < 4; ++m)
#pragma unroll
                for (int n = 0; n < 2; ++n) *(f32x4*)(base + (size_t)(row0 + ai * HALF + m * 16) * 128 + col0 + n * 16) = acc[ai][0][m][n];
    }
};
struct EpiSsmY { static constexpr bool PERM = true, AFTER_DRAIN = false;
    bf16* YACT;
    __device__ __forceinline__ void operator()(EPI_ARGS) const {
        const int n0 = u.pn * BM + wc * 32 + 8 * fq, row0 = wr * 64 + fr;
#pragma unroll
        for (int ai = 0; ai < 2; ++ai)
#pragma unroll
            for (int m = 0; m < 4; ++m) { const int r = row0 + ai * HALF + m * 16;
                if (u.pm < 4 || r < DECB) {
#pragma unroll
                    for (int bj = 0; bj < 2; ++bj) { const int n = n0 + bj * HALF, s = n >> 4, c0 = n & 15; const int tok = (u.pm < 4 ? u.pm * SEQ : MP) + r * CHUNK + s;
                        f32x4 v0 = acc[ai][bj][m][0], v1 = acc[ai][bj][m][1];
                        for (int i = 0; i < 4; ++i) { v0[i] = gelu_tanh_(v0[i]); v1[i] = gelu_tanh_(v1[i]); }
                        *(v4u*)(YACT + (size_t)tok * DSSM + u.g * 16 + c0) = pack8f(v0, v1); } } }
    }
};
struct SsmSched { const bf16* UH; const bf16* Bt; size_t bgrp, btile; int it0, it1, nit, upi;
    __device__ bool next(int i, Unit& u) const { if (i >= nit * upi) return false; const int li = i / upi, item = li == 0 ? it0 : it1; u.g = item / 5; u.pm = item % 5; u.pn = i % upi; return true; }
    __device__ __forceinline__ const char* a_ptr(const Unit& u) const { return (const char*)(UH + ((size_t)u.g * UHROWS + (size_t)u.pm * 256) * UHLD); }
    __device__ __forceinline__ const char* b_ptr(const Unit& u) const { return (const char*)Bt + (size_t)u.g * bgrp + (size_t)u.pn * btile; }
    __device__ __forceinline__ void a_ready(const Unit&) const {}
    __device__ __forceinline__ void done(const Unit&) const {}
};

__device__ __forceinline__ void p0_transpose_item(const float* W, int ldw, int src_col0, bf16* WT, int K, int dst_row0, int k0, LAS float* scr, int lane) {
#pragma unroll 8
    for (int i = 0; i < 32; ++i) { const int kk = 2 * i + (lane >> 5); scr[kk * 33 + (lane & 31)] = W[(size_t)(k0 + kk) * ldw + src_col0 + (lane & 31)]; }
    LDS_WAIT(); asm volatile("" ::: "memory");
    const int c = lane & 7;
#pragma unroll
    for (int j = 0; j < 4; ++j) { const int n = (lane >> 3) + 8 * j; const LAS float* s = scr + (8 * c) * 33 + n;
        v4u o; o.x = pk2(s[0 * 33], s[1 * 33]); o.y = pk2(s[2 * 33], s[3 * 33]); o.z = pk2(s[4 * 33], s[5 * 33]); o.w = pk2(s[6 * 33], s[7 * 33]);
        *(GAS v4u*)(WT + (size_t)(dst_row0 + n) * K + k0 + 8 * c) = o; }
    LDS_WAIT(); asm volatile("" ::: "memory");
}
__device__ __forceinline__ void ssm_tables(KArgs a, LAS unsigned char* lds, int g) {
    const int tid = threadIdx.x;
    LAS float* bbr = (LAS float*)lds;
    LAS float* bbi = bbr + 1024;
    LAS float* Cr = bbi + 1024;
    LAS float* Ci = Cr + 1024;
    LAS float* apr = Ci + 1024;
    LAS float* api = apr + 33 * 64;
    LAS float* Kc = api + 33 * 64;
    if (tid < 64) { const int p = tid;
        const double dt = exp((double)a->in[I_LDT][g]);
        const double ar = a->in[I_ARE][g * 64 + p], ai = a->in[I_AIM][g * 64 + p];
        const double mag = exp(ar * dt), ang = ai * dt; const double abr = mag * cos(ang), abi = mag * sin(ang);
        const double nr = abr - 1.0, ni = abi, den = ar * ar + ai * ai; const double cr = (nr * ar + ni * ai) / den, ci = (ni * ar - nr * ai) / den;
        for (int c = 0; c < 16; ++c) { const double br = a->in[I_BRE][(size_t)(g * 64 + p) * 16 + c], bi = a->in[I_BIM][(size_t)(g * 64 + p) * 16 + c];
            bbr[p * 16 + c] = (float)(cr * br - ci * bi); bbi[p * 16 + c] = (float)(cr * bi + ci * br); }
        double pr = 1.0, pi = 0.0;
        for (int t = 0; t <= 32; ++t) { apr[t * 64 + p] = (float)pr; api[t * 64 + p] = (float)pi; const double nr2 = pr * abr - pi * abi, ni2 = pr * abi + pi * abr; pr = nr2; pi = ni2; }
        float* A32 = (float*)(a->ws + WS_A32); A32[(g * 64 + p) * 2] = apr[32 * 64 + p]; A32[(g * 64 + p) * 2 + 1] = api[32 * 64 + p];
    }
    for (int e = tid; e < 1024; e += NTHR) { Cr[e] = a->in[I_CRE][(size_t)g * 1024 + e]; Ci[e] = a->in[I_CIM][(size_t)g * 1024 + e]; }
    __syncthreads();
    for (int e = tid; e < 8192; e += NTHR) { const int t = e >> 8, c = (e >> 4) & 15, c2 = e & 15; float sum = 0.f;
        for (int p = 0; p < 64; ++p) { const float car = Cr[c * 64 + p] * apr[t * 64 + p] - Ci[c * 64 + p] * api[t * 64 + p], cai = Cr[c * 64 + p] * api[t * 64 + p] + Ci[c * 64 + p] * apr[t * 64 + p];
            sum += car * bbr[p * 16 + c2] - cai * bbi[p * 16 + c2]; }
        if (t == 0 && c == c2) sum += a->in[I_DSK][g * 16 + c];
        Kc[e] = sum; }
    __syncthreads();
    bf16* MW = (bf16*)(a->ws + WS_MW_T) + (size_t)g * 512 * UHLD;
    for (int idx = tid; idx < 512 * 80; idx += NTHR) { const int n = idx / 80, k0 = (idx % 80) * 8, s = n >> 4, c = n & 15; float v[8];
        if (k0 < 512) { const int s2 = k0 >> 4, c0 = k0 & 15;
#pragma unroll
            for (int j = 0; j < 8; ++j) v[j] = s2 <= s ? Kc[((s - s2) * 16 + c) * 16 + c0 + j] : 0.f;
        } else if (k0 < 576) {
#pragma unroll
            for (int j = 0; j < 8; ++j) { const int p = k0 - 512 + j; v[j] = Cr[c * 64 + p] * apr[(s + 1) * 64 + p] - Ci[c * 64 + p] * api[(s + 1) * 64 + p]; }
        } else {
#pragma unroll
            for (int j = 0; j < 8; ++j) { const int p = k0 - 576 + j; v[j] = -(Cr[c * 64 + p] * api[(s + 1) * 64 + p] + Ci[c * 64 + p] * apr[(s + 1) * 64 + p]); }
        }
        v4u o; o.x = pk2(v[0], v[1]); o.y = pk2(v[2], v[3]); o.z = pk2(v[4], v[5]); o.w = pk2(v[6], v[7]);
        *(GAS v4u*)(MW + (size_t)n * UHLD + k0) = o; }
    bf16* BP = (bf16*)(a->ws + WS_BP_T) + (size_t)g * 256 * 512;
    for (int idx = tid; idx < 256 * 64; idx += NTHR) { const int n = idx >> 6, k0 = (idx & 63) * 8, s2 = k0 >> 4, c0 = k0 & 15; float v[8];
#pragma unroll
        for (int j = 0; j < 8; ++j) {
            if (n < 64) v[j] = apr[(31 - s2) * 64 + n] * bbr[n * 16 + c0 + j] - api[(31 - s2) * 64 + n] * bbi[n * 16 + c0 + j];
            else if (n < 128) { const int p = n - 64; v[j] = apr[(31 - s2) * 64 + p] * bbi[p * 16 + c0 + j] + api[(31 - s2) * 64 + p] * bbr[p * 16 + c0 + j]; }
            else v[j] = 0.f; }
        v4u o; o.x = pk2(v[0], v[1]); o.y = pk2(v[2], v[3]); o.z = pk2(v[4], v[5]); o.w = pk2(v[6], v[7]);
        *(GAS v4u*)(BP + (size_t)n * 512 + k0) = o; }
    __syncthreads();
}
__device__ __forceinline__ float log_sigmoid_(float z) { return z >= 0.f ? -log1pf(expf(-z)) : z - log1pf(expf(z)); }
__device__ __forceinline__ void phase0(KArgs a, LAS unsigned char* lds) {
    const int tid = threadIdx.x, lane = tid & 63, wave = __builtin_amdgcn_readfirstlane(tid >> 6);
    const int gw = blockIdx.x * NWAVES + wave, NGW = gridDim.x * NWAVES;
    if (blockIdx.x < NG) ssm_tables(a, lds, blockIdx.x);
    { LAS float* scr = (LAS float*)(lds + wave * 16384);
      constexpr int I_IN = 32 * 192, I_GLU = 16 * 32, I_OUT = 32 * 64, I_PE = 4 * 64, I_PG = 32 * 64, NITEMS = I_IN + I_GLU + I_OUT + I_PE + I_PG;
      for (int it = gw; it < NITEMS; it += NGW) { int r = it;
          if (r < I_IN) { const int kb = r / 192, nb = r % 192; p0_transpose_item(a->in[I_WIN], DIN, 32 * nb + (nb >= 96 ? 8 : 0), (bf16*)(a->ws + WS_WIN_T), DM, 32 * nb, 64 * kb, scr, lane); continue; } r -= I_IN;
          if (r < I_GLU) { const int kb = r / 32, nb = r % 32; p0_transpose_item(a->in[I_WGLU], DSSM, 32 * nb, (bf16*)(a->ws + WS_WGLU_T), DSSM, 32 * nb, 64 * kb, scr, lane); continue; } r -= I_GLU;
          if (r < I_OUT) { const int kb = r / 64, nb = r % 64; p0_transpose_item(a->in[I_WOUT], DM, 32 * nb, (bf16*)(a->ws + WS_WOUT_T), DM, 32 * nb, 64 * kb, scr, lane); continue; } r -= I_OUT;
          if (r < I_PE) { const int kb = r / 64, nb = r % 64; p0_transpose_item(a->in[I_WPE], DM, 32 * nb, (bf16*)(a->ws + WS_WPE_T), DPLE, 32 * nb, 64 * kb, scr, lane); continue; } r -= I_PE;
          { const int kb = r / 64, nb = r % 64; p0_transpose_item(a->in[I_WPG], DM, 32 * nb, (bf16*)(a->ws + WS_WPG_T), DM, 32 * nb, 64 * kb, scr, lane); } } }
    __syncthreads();
    LAS float* wfT = (LAS float*)lds;
    for (int e = tid; e < DM * NH; e += NTHR) { const int k = e >> 3, h = e & 7; wfT[h * DM + k] = a->in[I_WIN][(size_t)k * DIN + OFF_F + h]; }
    __syncthreads();
    f32x4 gi[8];
#pragma unroll
    for (int j = 0; j < 8; ++j) gi[j] = *(const f32x4*)(a->in[I_GIN] + 256 * j + 4 * lane);
    const float bfh = a->in[I_BF][lane & 7];
    float* LOGF = (float*)(a->ws + WS_LOGF);
    for (int row = gw; row < MT; row += NGW) {
        const bool pr = row < MP;
        const float* xr = pr ? a->in[I_XP] + (size_t)row * DM : a->in[I_XS] + (size_t)(row - MP) * DM;
        f32x4 v[8]; float ss = 0.f;
#pragma unroll
        for (int j = 0; j < 8; ++j) { v[j] = *(const f32x4*)(xr + 256 * j + 4 * lane); ss += (v[j][0] * v[j][0] + v[j][1] * v[j][1]) + (v[j][2] * v[j][2] + v[j][3] * v[j][3]); }
        const float rstd = 1.0f / sqrtf(wave_sum(ss) * (1.0f / DM) + EPS);
        bf16* xo = (bf16*)(a->ws + WS_XN) + (size_t)row * DM;
#pragma unroll
        for (int j = 0; j < 8; ++j) { v[j] = v[j] * rstd * gi[j]; v2u w; w.x = pk2(v[j][0], v[j][1]); w.y = pk2(v[j][2], v[j][3]); *(GAS v2u*)(xo + 256 * j + 4 * lane) = w; }
        float mine = 0.f;
#pragma unroll 1
        for (int h = 0; h < 8; ++h) { float s = 0.f;
#pragma unroll
            for (int j = 0; j < 8; ++j) { const f32x4 w = *(const LAS f32x4*)(wfT + h * DM + 256 * j + 4 * lane); s += (v[j][0] * w[0] + v[j][1] * w[1]) + (v[j][2] * w[2] + v[j][3] * w[3]); }
            s = wave_sum(s); mine = (lane & 7) == h ? s : mine; }
        if (lane < 8) { const float lf = log_sigmoid_(mine + bfh); LOGF[(size_t)row * 8 + lane] = lf;
            (pr ? a->out + O_LFP + (size_t)row * 8 : a->out + O_LFS + (size_t)(row - MP) * 8)[lane] = lf; }
        const float* prow = pr ? a->in[I_PP] + (size_t)row * DPLE : a->in[I_PS] + (size_t)(row - MP) * DPLE;
        const f32x4 pv = *(const f32x4*)(prow + 4 * lane); v2u w; w.x = pk2(pv[0], pv[1]); w.y = pk2(pv[2], pv[3]);
        *(GAS v2u*)((bf16*)(a->ws + WS_PB) + (size_t)row * DPLE + 4 * lane) = w;
    }
}
__device__ __forceinline__ void forget_cumsum(KArgs a, LAS unsigned char* lds) {
    const int bid = blockIdx.x, tid = threadIdx.x;
    if (bid < NB + DECB) {
        LAS double* sseg = (LAS double*)lds;
        const int h = tid & 7, seg = tid >> 3; const float* LOGF = (const float*)(a->ws + WS_LOGF);
        const bool pr = bid < NB; const int b = pr ? bid : bid - NB, n = pr ? SEQ : PAST + DECS, L = pr ? 128 : 65;
        const float* s0 = pr ? LOGF + (size_t)b * SEQ * 8 + h : a->in[I_CLF] + (size_t)b * PAST * 8 + h;
        const float* s1 = LOGF + ((size_t)MP + (size_t)b * DECS) * 8 + h;
        const int n0 = pr ? SEQ : PAST;
        float* out = pr ? (float*)(a->ws + WS_CP) + (size_t)(b * NH + h) * SEQ : (float*)(a->ws + WS_CS) + (size_t)(b * NH + h) * CSLD;
        const int t0 = seg * L, t1 = (t0 + L < n) ? t0 + L : n;
        double s = 0.0;
        for (int t = t0; t < t1; ++t) s += (double)(t < n0 ? s0[(size_t)t * 8] : s1[(size_t)(t - n0) * 8]);
        sseg[seg * 8 + h] = s; __syncthreads();
        double pre = 0.0; for (int j = 0; j < seg; ++j) pre += sseg[j * 8 + h];
        for (int t = t0; t < t1; ++t) { pre += (double)(t < n0 ? s0[(size_t)t * 8] : s1[(size_t)(t - n0) * 8]); out[t] = (float)(pre * 11.313708498984761); }
        if (!pr && seg == 63) { const float last = (float)(pre * 11.313708498984761); for (int t = n; t < CSLD; ++t) out[t] = last; }
        __syncthreads();
    }
}
__device__ __forceinline__ void ssm_scan(KArgs a, int item, int lane) {
    const int g = item / 5, u = item % 5, p = lane;
    const float* S = (const float*)(a->ws + WS_SBUF) + (size_t)item * 256 * 128;
    bf16* UH = (bf16*)(a->ws + WS_UH) + ((size_t)g * UHROWS + (size_t)u * 256) * UHLD;
    const float a32r = ((const float*)(a->ws + WS_A32))[(g * 64 + p) * 2], a32i = ((const float*)(a->ws + WS_A32))[(g * 64 + p) * 2 + 1];
    if (u < 4) {
        float hr = 0.f, hi = 0.f;
        for (int j = 0; j < 256; ++j) {
            UH[(size_t)j * UHLD + 512 + p] = (bf16)f2bf(hr); UH[(size_t)j * UHLD + 576 + p] = (bf16)f2bf(hi);
            const float sr = S[j * 128 + p], si = S[j * 128 + 64 + p];
            const float nr = a32r * hr - a32i * hi + sr, ni = a32r * hi + a32i * hr + si; hr = nr; hi = ni; }
        a->out[O_SRP + (size_t)(u * NG + g) * NST + p] = hr; a->out[O_SIP + (size_t)(u * NG + g) * NST + p] = hi;
    } else {
        for (int j = 0; j < DECB; ++j) {
            const float hr = a->in[I_SRE][(size_t)(j * NG + g) * NST + p], hi = a->in[I_SIM][(size_t)(j * NG + g) * NST + p];
            UH[(size_t)j * UHLD + 512 + p] = (bf16)f2bf(hr); UH[(size_t)j * UHLD + 576 + p] = (bf16)f2bf(hi);
            const float sr = S[j * 128 + p], si = S[j * 128 + 64 + p];
            a->out[O_SRS + (size_t)(j * NG + g) * NST + p] = a32r * hr - a32i * hi + sr; a->out[O_SIS + (size_t)(j * NG + g) * NST + p] = a32r * hi + a32i * hr + si; }
    }
}
constexpr float PRUNE_T = 36.0f;
__device__ __forceinline__ float dpp_max_step(float v, const int ctrl_sel) {
    int x = __float_as_int(v), y;
    if (ctrl_sel == 0) y = __builtin_amdgcn_update_dpp(x, x, 0xB1, 0xF, 0xF, false);
    else if (ctrl_sel == 1) y = __builtin_amdgcn_update_dpp(x, x, 0x4E, 0xF, 0xF, false);
    else if (ctrl_sel == 2) y = __builtin_amdgcn_update_dpp(x, x, 0x141, 0xF, 0xF, false);
    else y = __builtin_amdgcn_update_dpp(x, x, 0x140, 0xF, 0xF, false);
    return fmaxf(v, __int_as_float(y));
}
__device__ __forceinline__ float block_max(float v, LAS float* red, int lane, int wave) {
    v = dpp_max_step(v, 0); v = dpp_max_step(v, 1); v = dpp_max_step(v, 2); v = dpp_max_step(v, 3);
    const float w = fmaxf(fmaxf(__int_as_float(__builtin_amdgcn_readlane(__float_as_int(v), 0)), __int_as_float(__builtin_amdgcn_readlane(__float_as_int(v), 16))),
                          fmaxf(__int_as_float(__builtin_amdgcn_readlane(__float_as_int(v), 32)), __int_as_float(__builtin_amdgcn_readlane(__float_as_int(v), 48))));
    __syncthreads(); if (lane == 0) red[wave] = w; __syncthreads();
    float m = red[0];
#pragma unroll
    for (int k = 1; k < NWAVES; ++k) m = fmaxf(m, red[k]);
    return __uint_as_float(__builtin_amdgcn_readfirstlane(__float_as_uint(m)));
}
__device__ __forceinline__ float fox_kmax2(KArgs a, int bh, LAS float* red, int tid) {
    asm volatile("" : "+v"(tid));
    const int b = bh >> 3, h = bh & 7; const float* KSS = (const float*)(a->ws + WS_KSS); float m = 0.f;
    for (int t = tid; t < SEQ; t += NTHR) { const f32x4 v = *(const f32x4*)(KSS + ((size_t)(b * SEQ + t) * 8 + h) * 4); m = fmaxf(m, (v[0] + v[1]) + (v[2] + v[3])); }
    return block_max(m, red, tid & 63, tid >> 6);
}
__device__ __forceinline__ int fox_jlo(KArgs a, int bh, int qb, float kmax2, LAS float* red, int tid) {
    asm volatile("" : "+v"(tid));
    const int b = bh >> 3, h = bh & 7, P0 = qb * 256; const float* QSS = (const float*)(a->ws + WS_QSS); float q2 = 0.f;
    if (tid < 256) { const f32x4 v = *(const f32x4*)(QSS + ((size_t)(b * SEQ + P0 + tid) * 8 + h) * 4); q2 = (v[0] + v[1]) + (v[2] + v[3]); }
    const float qmax2 = block_max(q2, red, tid & 63, tid >> 6);
    const float B = sqrtf(qmax2 * kmax2) * att::SCALE * 1.02f;
    const float thr = (PRUNE_T + 2.0f * B) * 11.313708498984761f;
    const float* cp = (const float*)(a->ws + WS_CP) + (size_t)(b * NH + h) * SEQ;
    const bool skip = tid < 4 * qb && cp[64 * tid + 63] - cp[P0] > thr;
    const float cnt = (float)__popcll(__ballot(skip));
    __syncthreads(); if ((tid & 63) == 0) red[8 + (tid >> 6)] = cnt; __syncthreads();
    return __builtin_amdgcn_readfirstlane((int)(red[8] + red[9]));
}
__device__ __forceinline__ att::BlockRef<att::bf16> prompt_ref(KArgs a, int bh, int qb, int jlo) {
    const int b = bh >> 3, h = bh & 7; att::BlockRef<att::bf16> r;
    const size_t row0 = (size_t)b * SEQ + (size_t)qb * 256, key0 = (size_t)b * SEQ + (size_t)jlo * 64;
    r.Q = (const bf16*)(a->ws + WS_Q) + row0 * 1024 + h * HD; r.K = (const bf16*)(a->ws + WS_K) + key0 * 1024 + h * HD; r.V = (const bf16*)(a->ws + WS_V) + key0 * 1024 + h * HD;
    r.Kn = r.K; r.Vn = r.V; r.O = (bf16*)(a->ws + WS_MIXED) + row0 * DM + h * HD; r.G = (const bf16*)(a->ws + WS_SGA) + row0 * 1024 + h * HD;
    const float* cp = (const float*)(a->ws + WS_CP) + (size_t)(b * NH + h) * SEQ;
    r.CK = cp + jlo * 64; r.CQ = cp + qb * 256; r.np = 0x7fffffff; r.P0 = qb * 256 - jlo * 64; r.jhi = 4 * qb + 4 - jlo;
    return r;
}
__device__ __forceinline__ att::BlockRef<float> sample_ref(KArgs a, int bh) {
    const int b = bh >> 3, h = bh & 7; att::BlockRef<float> r;
    const size_t row0 = (size_t)MP + (size_t)b * DECS;
    r.Q = (const bf16*)(a->ws + WS_Q) + row0 * 1024 + h * HD; r.K = a->in[I_CK] + (size_t)b * PAST * 1024 + h * HD; r.V = a->in[I_CV] + (size_t)b * PAST * 1024 + h * HD;
    r.Kn = a->out + O_KS + (size_t)b * DECS * 1024 + h * HD; r.Vn = a->out + O_VS + (size_t)b * DECS * 1024 + h * HD;
    r.O = (bf16*)(a->ws + WS_MIXED) + row0 * DM + h * HD; r.G = (const bf16*)(a->ws + WS_SGA) + row0 * 1024 + h * HD;
    r.CK = (const float*)(a->ws + WS_CS) + (size_t)(b * NH + h) * CSLD; r.CQ = r.CK + PAST; r.np = PAST; r.P0 = PAST; r.jhi = (PAST + 64) / 64;
    return r;
}

__global__ void __launch_bounds__(NTHR, 2) fox_s5_fwd(Args args) {
    extern __shared__ __attribute__((aligned(16))) unsigned char lds_raw[];
    LAS unsigned char* lds = (LAS unsigned char*)lds_raw;
    const int G = gridDim.x, bid = blockIdx.x;
#define THREAD_IDS() int tid = threadIdx.x; asm volatile("" : "+v"(tid)); const int lane = tid & 63, wave = __builtin_amdgcn_readfirstlane(tid >> 6); (void)lane; (void)wave
    { THREAD_IDS(); for (int u = tid; u < (LDS_BYTES - LDSCTL_OFF) / 4; u += NTHR) ((LAS unsigned*)(lds + LDSCTL_OFF))[u] = 0u; }
    __syncthreads();
#if MK_ONE_LAUNCH
    XcdBarrier bar = xcd_barrier_post((unsigned*)(args.ws + WS_CTL) + CW_BAR, (volatile LAS unsigned*)(lds + MISC_OFF) + 8);
#define GRID_BAR() xcd_barrier(bar)
#else
#define GRID_BAR() do {} while (0)
#endif
    const int lo = args.ph_lo, hi = args.ph_hi;
#ifdef ONLY_PH
#define IN(k) ((k) == ONLY_PH && lo <= (k) && (k) < hi)
#else
#define IN(k) (lo <= (k) && (k) < hi)
#endif
#define BOTH(k) (IN(k) && IN((k) + 1))

    if (IN(0)) { KArgs A = launder_kernarg(); unsigned char* ws = A->ws; (void)ws; phase0(A, lds); if (BOTH(0)) GRID_BAR(); }

    if (IN(1)) { KArgs A = launder_kernarg(); unsigned char* ws = A->ws; (void)ws;
        forget_cumsum(A, lds);
        { pg8::Gemm g{DM, DM, DM}; pg8::StaticOrder S; S.init((const bf16*)(ws + WS_XN), (const bf16*)(ws + WS_WIN_T), DM, DM, MT, NIN, G, bid);
          EpiInProj E{(bf16*)(ws + WS_Q), (bf16*)(ws + WS_K), (bf16*)(ws + WS_V), (bf16*)(ws + WS_SGA), (bf16*)(ws + WS_SGS), (bf16*)(ws + WS_UH),
                      A->out + O_KP, A->out + O_VP, A->out + O_KS, A->out + O_VS, (float*)(ws + WS_QSS), (float*)(ws + WS_KSS)};
          pg8::gemm_phase<EpiInProj, pg8::StaticOrder, true, true>(lds + RING_OFF, g, S, E); }
        { pg8::Gemm g{DPLE, DPLE, DPLE}; pg8::StaticOrder S; S.init((const bf16*)(ws + WS_PB), (const bf16*)(ws + WS_WPE_T), DPLE, DPLE, MT, DM, G, bid);
          EpiPle E{(bf16*)(ws + WS_E), (float*)(ws + WS_ESS)};
          pg8::gemm_phase<EpiPle, pg8::StaticOrder, true, true>(lds + RING_OFF, g, S, E); }
        if (BOTH(1)) GRID_BAR();
    }

    if (IN(2)) { KArgs A = launder_kernarg(); unsigned char* ws = A->ws; (void)ws; THREAD_IDS();
#ifndef NO_SSM
        { const int it0 = bid, it1 = bid + G, nit = it0 < NSSM_ITEMS ? (it1 < NSSM_ITEMS ? 2 : 1) : 0;
          if (nit > 0) {
            { pg8::Gemm g{UHLD, 512, 512}; SsmSched S{(const bf16*)(ws + WS_UH), (const bf16*)(ws + WS_BP_T), (size_t)256 * 512 * 2, 0, it0, it1, nit, 1};
              EpiSsmS E{(float*)(ws + WS_SBUF)};
              pg8::gemm_phase<EpiSsmS, SsmSched, false, true>(lds + RING_OFF, g, S, E); }
            VM_WAIT(); __syncthreads();
            if (wave < nit) ssm_scan(A, wave == 0 ? it0 : it1, lane);
            VM_WAIT(); __syncthreads();
            { pg8::Gemm g{UHLD, UHLD, UHLD}; SsmSched S{(const bf16*)(ws + WS_UH), (const bf16*)(ws + WS_MW_T), (size_t)512 * UHLD * 2, (size_t)256 * UHLD * 2, it0, it1, nit, 2};
              EpiSsmY E{(bf16*)(ws + WS_YACT)};
              pg8::gemm_phase<EpiSsmY, SsmSched, false, true>(lds + RING_OFF, g, S, E); }
          } }
#endif
        __syncthreads();
#ifndef NO_PATT
        { att::Seam S; int L = bid; LAS float* red = (LAS float*)(lds + RING_OFF + 65536);
          if (L < 512) {
            int pass = 0; float km2 = fox_kmax2(A, L >> 4, red, tid);
            att::BlockRef<att::bf16> cur = prompt_ref(A, L >> 4, L & 15, fox_jlo(A, L >> 4, L & 15, km2, red, tid));
            att::fox_prime<att::bf16, false>(cur, (char*)lds_raw + RING_OFF, S);
            for (;;) {
                int Ln = L, passn = pass + 1; if (pass == 1) { passn = 0; Ln = L + G; }
                const bool last = Ln >= 512;
                const int qbn = passn == 0 ? (Ln & 15) : 31 - (Ln & 15); int jn = 0;
                if (!last) { if (passn == 0) km2 = fox_kmax2(A, Ln >> 4, red, tid); jn = fox_jlo(A, Ln >> 4, qbn, km2, red, tid); }
                const att::BlockRef<att::bf16> nxt = last ? cur : prompt_ref(A, Ln >> 4, qbn, jn);
                att::fox_block<att::bf16, false>(cur, nxt, (char*)lds_raw + RING_OFF, S);
                if (last) break;
                cur = nxt; L = Ln; pass = passn;
            } } }
#endif
        __syncthreads();
#ifndef NO_SATT
        { att::Seam S;
          for (int L = bid; L < DECB * NH; L += G) {
            const att::BlockRef<float> cur = sample_ref(A, L);
            att::fox_prime<float, true>(cur, (char*)lds_raw + RING_OFF, S);
            att::fox_block<float, true>(cur, cur, (char*)lds_raw + RING_OFF, S);
            VM_WAIT(); __syncthreads();
          } }
#endif
        if (BOTH(2)) GRID_BAR();
    }

    if (IN(3)) { KArgs A = launder_kernarg(); unsigned char* ws = A->ws; (void)ws; THREAD_IDS();
        { const int rpb = (MT + G - 1) / G; const int row = bid * rpb + tid;
          if (tid < rpb && row < MT) { const f32x4* p = (const f32x4*)((const float*)(ws + WS_ESS) + (size_t)row * 32); float ss = 0.f;
#pragma unroll
              for (int j = 0; j < 8; ++j) { const f32x4 v = p[j]; ss += (v[0] + v[1]) + (v[2] + v[3]); }
              ((float*)(ws + WS_RSTDE))[row] = 1.0f / sqrtf(ss * (1.0f / DM) + EPS); } }
        { pg8::Gemm g{DSSM, DSSM, DSSM}; pg8::StaticOrder S; S.init((const bf16*)(ws + WS_YACT), (const bf16*)(ws + WS_WGLU_T), DSSM, DSSM, MT, DSSM, G, bid);
          EpiGlu E{(const bf16*)(ws + WS_YACT), (const bf16*)(ws + WS_SGS), (bf16*)(ws + WS_MIXED)};
          pg8::gemm_phase<EpiGlu, pg8::StaticOrder, true, true>(lds + RING_OFF, g, S, E); }
        if (BOTH(3)) GRID_BAR();
    }

    if (IN(4)) { KArgs A = launder_kernarg(); unsigned char* ws = A->ws; (void)ws;
        { pg8::Gemm g{DM, DM, DM}; pg8::StaticOrder S; S.init((const bf16*)(ws + WS_MIXED), (const bf16*)(ws + WS_WOUT_T), DM, DM, MT, DM, G, bid);
          EpiOut E{A->in[I_XP], A->in[I_XS], (bf16*)(ws + WS_HB)};
          pg8::gemm_phase<EpiOut, pg8::StaticOrder, true, true>(lds + RING_OFF, g, S, E); }
        if (BOTH(4)) GRID_BAR();
    }

    if (IN(5)) { KArgs A = launder_kernarg(); unsigned char* ws = A->ws; (void)ws;
        { pg8::Gemm g{DM, DM, DM}; pg8::StaticOrder S; S.init((const bf16*)(ws + WS_HB), (const bf16*)(ws + WS_WPG_T), DM, DM, MT, DM, G, bid);
          EpiPg E{(const bf16*)(ws + WS_HB), (bf16*)(ws + WS_MIXED)  , (const bf16*)(ws + WS_E), (const float*)(ws + WS_RSTDE), A->in[I_GPE], (float*)(ws + WS_H2SS)};
          pg8::gemm_phase<EpiPg, pg8::StaticOrder, true, true>(lds + RING_OFF, g, S, E); }
        if (BOTH(5)) GRID_BAR();
    }

    if (IN(6)) { KArgs A = launder_kernarg(); unsigned char* ws = A->ws; (void)ws; THREAD_IDS();
        const int gw = bid * NWAVES + wave, NGW = G * NWAVES;
        f32x4 gf[8];
#pragma unroll
        for (int j = 0; j < 8; ++j) gf[j] = *(const f32x4*)(A->in[I_GFIN] + 512 * (j >> 1) + 8 * lane + 4 * (j & 1));
        for (int row = gw; row < MT; row += NGW) {
            float ss = lane < 32 ? ((const float*)(ws + WS_H2SS))[(size_t)row * 32 + lane] : 0.f;
            const float rstd = 1.0f / sqrtf(wave_sum(ss) * (1.0f / DM) + EPS);
            float* yr = row < MP ? A->out + O_YP + (size_t)row * DM : A->out + O_YS + (size_t)(row - MP) * DM;
            const bf16* hr = (const bf16*)(ws + WS_MIXED) + (size_t)row * DM;
#pragma unroll
            for (int j = 0; j < 4; ++j) { const v4u w = *(const v4u*)(hr + 512 * j + 8 * lane);
                f32x4 v0, v1; v0[0] = bf_lo(w.x); v0[1] = bf_hi(w.x); v0[2] = bf_lo(w.y); v0[3] = bf_hi(w.y); v1[0] = bf_lo(w.z); v1[1] = bf_hi(w.z); v1[2] = bf_lo(w.w); v1[3] = bf_hi(w.w);
                *(f32x4*)(yr + 512 * j + 8 * lane) = v0 * rstd * gf[2 * j]; *(f32x4*)(yr + 512 * j + 8 * lane + 4) = v1 * rstd * gf[2 * j + 1]; }
        }
    }
#undef IN
#undef BOTH
}
constexpr int NPHASE = 7;

extern "C" void kernel_launch(void* const* d_in, const int* in_sizes, int n_in, void* d_out, int out_size, void* d_ws, size_t ws_size, hipStream_t stream) {
    static int grid = 0;
    if (grid == 0) {
        if (n_in != N_IN || in_sizes[0] != MP * DM || (size_t)out_size != O_END || ws_size < WS_END) {
            fprintf(stderr, "kernel_launch: unexpected shapes (n_in %d, in0 %d, out %d, ws %zu); nothing launched\n", n_in, n_in > 0 ? in_sizes[0] : -1, out_size, ws_size); grid = -1; return; }
        int dev = 0, cus = 0, per_cu = 0;
        if (hipGetDevice(&dev) != hipSuccess || hipDeviceGetAttribute(&cus, hipDeviceAttributeMultiprocessorCount, dev) != hipSuccess) { grid = -1; return; }
        if (hipFuncSetAttribute((const void*)fox_s5_fwd, hipFuncAttributeMaxDynamicSharedMemorySize, LDS_BYTES) != hipSuccess) { fprintf(stderr, "kernel_launch: hipFuncSetAttribute failed\n"); grid = -1; return; }
        if (hipOccupancyMaxActiveBlocksPerMultiprocessor(&per_cu, (const void*)fox_s5_fwd, NTHR, LDS_BYTES) != hipSuccess || per_cu < 1)
            fprintf(stderr, "kernel_launch: note: occupancy query reports %d workgroups per CU\n", per_cu);
        (void)hipGetLastError();
        grid = cus;
    }
    if (grid < 0) return;
    (void)hipMemsetAsync((char*)d_ws + WS_CTL, 0, CTL_ZERO_BYTES, stream);
    Args a{};
    for (int i = 0; i < N_IN; ++i) a.in[i] = (const float*)d_in[i];
    a.out = (float*)d_out; a.ws = (unsigned char*)d_ws;
#if MK_ONE_LAUNCH
    a.ph_lo = 0; a.ph_hi = NPHASE;
    hipLaunchKernelGGL(fox_s5_fwd, dim3(grid), dim3(NTHR), LDS_BYTES, stream, a);
#else
    for (int ph = 0; ph < NPHASE; ++ph) { a.ph_lo = ph; a.ph_hi = ph + 1; hipLaunchKernelGGL(fox_s5_fwd, dim3(grid), dim3(NTHR), LDS_BYTES, stream, a);
#ifdef PROBE_REP
        if (ph == PROBE_REP) { const int r0 = PROBE_REP >= 5 ? 4 : PROBE_REP;
            for (int p2 = r0; p2 <= PROBE_REP; ++p2) { a.ph_lo = p2; a.ph_hi = p2 + 1; hipLaunchKernelGGL(fox_s5_fwd, dim3(grid), dim3(NTHR), LDS_BYTES, stream, a); } }
#endif
    }
#endif
}
```

```cpp
#include <hip/hip_runtime.h>
#include <cstdio>
#include <cstdint>

#ifndef MK_ONE_LAUNCH
#define MK_ONE_LAUNCH 1
#endif
#ifndef DBG_GP
#define DBG_GP 0
#endif

namespace pg8 {
#define PG8_LAS __attribute__((address_space(3)))
typedef unsigned short bf16_t;
typedef short bf16x8 __attribute__((ext_vector_type(8)));
typedef float f32x4 __attribute__((ext_vector_type(4)));
typedef unsigned u32x4 __attribute__((ext_vector_type(4)));
constexpr int BM = 256, BK = 64, HALF = 128, HTB = HALF * BK * 2  , STAGE_BYTES = 8 * HTB, NXCD = 8, WGM = 8;

__host__ __device__ __forceinline__ int lds_byte(int r, int c) { const int st = (r >> 4) * 2 + (c >> 5), rr = r & 15, cc = c & 31, ob = rr * 64 + cc * 2; return st * 1024 + (ob ^ (((ob >> 9) & 1) << 5)); }
__host__ __device__ __forceinline__ void stage_rc(int b, int& R, int& C) { const int st = b / 1024, sb = b % 1024, swz = sb ^ (((sb >> 9) & 1) << 5); R = (st >> 1) * 16 + swz / 64; C = (st & 1) * 32 + (swz % 64) / 2; }
__host__ __device__ __forceinline__ int perm32(int rho) { const int n = rho >> 4, i = rho & 15; return 8 * (i >> 2) + 4 * n + (i & 3); }

struct Unit { int pm, pn, g; };
struct Gemm { int lda, ldb, K; };

struct StaticOrder {
    const bf16_t* A; const bf16_t* Bt; size_t ta, tb;
    int nM, nN, nwg, G, c;
    __device__ void init(const bf16_t* A_, const bf16_t* Bt_, int lda, int ldb, int M, int N, int G_, int c_) { A = A_; Bt = Bt_; ta = (size_t)BM * lda * 2; tb = (size_t)BM * ldb * 2; nM = M / BM; nN = N / BM; nwg = nM * nN; G = G_; c = c_; }
    __device__ bool next(int i, Unit& u) const {
        const long L = (long)i * G + c; if (L >= nwg) return false;
        int wgid = (int)L; { const int q = nwg / NXCD, r = nwg % NXCD, xcd = wgid % NXCD, off = wgid / NXCD; wgid = (xcd < r ? xcd * (q + 1) : r * (q + 1) + (xcd - r) * q) + off; }
        const int nig = WGM * nN, gid = wgid / nig, fm = gid * WGM, gsz = (nM - fm) < WGM ? (nM - fm) : WGM;
        u.pm = fm + ((wgid % nig) % gsz); u.pn = (wgid % nig) / gsz; u.g = 0; return true;
    }
    __device__ __forceinline__ const char* a_ptr(const Unit& u) const { return (const char*)A + (size_t)u.pm * ta; }
    __device__ __forceinline__ const char* b_ptr(const Unit& u) const { return (const char*)Bt + (size_t)u.pn * tb; }
    __device__ __forceinline__ void a_ready(const Unit&) const {}
    __device__ __forceinline__ void done(const Unit&) const {}
};

__device__ __forceinline__ unsigned cvt_pk_bf16(float lo, float hi) { unsigned r; asm("v_cvt_pk_bf16_f32 %0, %1, %2" : "=v"(r) : "v"(lo), "v"(hi)); return r; }
__device__ __forceinline__ float bf_lo(unsigned w) { return __uint_as_float(w << 16); }
__device__ __forceinline__ float bf_hi(unsigned w) { return __uint_as_float(w & 0xffff0000u); }
__device__ __forceinline__ float sigmoidf_(float x) { return __builtin_amdgcn_rcpf(1.0f + __builtin_amdgcn_exp2f(-1.4426950408889634f * x)); }
__device__ __forceinline__ float siluf_(float x) { return x * sigmoidf_(x); }
__device__ __forceinline__ float gelu_tanh_(float x) { const float t = 0.7978845608028654f * (x + 0.044715f * x * x * x); return x * sigmoidf_(2.0f * t); }
__device__ __forceinline__ u32x4 pack8f(const f32x4& a, const f32x4& b) { u32x4 w; w.x = cvt_pk_bf16(a[0], a[1]); w.y = cvt_pk_bf16(a[2], a[3]); w.z = cvt_pk_bf16(b[0], b[1]); w.w = cvt_pk_bf16(b[2], b[3]); return w; }

template <class Epi, class Sched, bool ALIGN_EPI = false, bool SP2 = false>
__device__ __forceinline__ void gemm_phase(PG8_LAS unsigned char* lds, const Gemm g, const Sched& S, const Epi& E) {
    const int tid = threadIdx.x, wid = __builtin_amdgcn_readfirstlane(tid >> 6), lane = tid & 63, wr = wid >> 2, wc = wid & 3, fr = lane & 15, fq = lane >> 4;
    const int K = g.K, nt = K / BK;
    unsigned voffA[2], voffB[2];
#pragma unroll
    for (int i = 0; i < 2; ++i) { int R, C; stage_rc(tid * 16 + i * 8192, R, C); const int Rb = Epi::PERM ? ((R & ~31) + perm32(R & 31)) : R;
        voffA[i] = (unsigned)(R * g.lda + C) * 2u; voffB[i] = (unsigned)(Rb * g.ldb + C) * 2u; }
    const size_t kstep = (size_t)(BK * 2);
    const size_t hstepA = (size_t)HALF * g.lda * 2, hstepB = (size_t)HALF * g.ldb * 2;
    const unsigned ldsw = (unsigned)wid * 1024u;
    const int aoff = lds_byte(wr * 64 + fr, fq * 8), boff = lds_byte(wc * 32 + fr, fq * 8);
#define PG8_SA(b, h) (((b) * 2 + (h)) * HTB)
#define PG8_SB(b, h) ((4 + (b) * 2 + (h)) * HTB)
#define PG8_STAGE(bufoff, gbase, voff) do { _Pragma("unroll") for (int _i = 0; _i < 2; ++_i) \
        __builtin_amdgcn_global_load_lds((const unsigned*)((const char*)(gbase) + (voff)[_i]), (PG8_LAS unsigned*)(lds + (bufoff) + ldsw + _i * 8192), 16, 0, 0); } while (0)
#define PG8_LDA(dst, b, h) do { _Pragma("unroll") for (int m = 0; m < 4; ++m) _Pragma("unroll") for (int k = 0; k < 2; ++k) dst[m][k] = *(const PG8_LAS bf16x8*)(lds + PG8_SA(b, h) + aoff + m * 2048 + k * 1024); } while (0)
#define PG8_LDB(dst, b, h) do { _Pragma("unroll") for (int n = 0; n < 2; ++n) _Pragma("unroll") for (int k = 0; k < 2; ++k) dst[n][k] = *(const PG8_LAS bf16x8*)(lds + PG8_SB(b, h) + boff + n * 2048 + k * 1024); } while (0)
#define PG8_MMA(ai, bj, At, Bt) do { __builtin_amdgcn_s_setprio(1); _Pragma("unroll") for (int m = 0; m < 4; ++m) _Pragma("unroll") for (int n = 0; n < 2; ++n) _Pragma("unroll") for (int k = 0; k < 2; ++k) \
        acc[ai][bj][m][n] = __builtin_amdgcn_mfma_f32_16x16x32_bf16(Bt[n][k], At[m][k], acc[ai][bj][m][n], 0, 0, 0); __builtin_amdgcn_s_setprio(0); } while (0)
#define PG8_WAIT_V(n) asm volatile("s_waitcnt vmcnt(" #n ")" ::: "memory")
#define PG8_WAIT_L(n) asm volatile("s_waitcnt lgkmcnt(" #n ")" ::: "memory")
#define PG8_BAR __builtin_amdgcn_s_barrier()
#define PG8_SCHED __builtin_amdgcn_sched_barrier(0)
    Unit cur, nxt; int ui = 0;
    if (!S.next(0, cur)) return;
    f32x4 acc[2][2][4][2];
#pragma unroll
    for (int a = 0; a < 2; ++a)
#pragma unroll
        for (int b = 0; b < 2; ++b)
#pragma unroll
            for (int m = 0; m < 4; ++m)
#pragma unroll
                for (int n = 0; n < 2; ++n) acc[a][b][m][n] = (f32x4){0.f, 0.f, 0.f, 0.f};
    bf16x8 At[4][2], B0[2][2], B1[2][2];
    const char* cA = S.a_ptr(cur); const char* cB = S.b_ptr(cur);
    S.a_ready(cur);
    if constexpr (SP2) {
        PG8_STAGE(PG8_SB(0, 0), cB, voffB); PG8_STAGE(PG8_SB(0, 1), cB + hstepB, voffB); PG8_STAGE(PG8_SA(0, 0), cA, voffA); PG8_STAGE(PG8_SA(0, 1), cA + hstepA, voffA);
        if (wr == 1) PG8_BAR;
        PG8_WAIT_V(2); PG8_BAR;
        PG8_STAGE(PG8_SB(1, 0), cB + kstep, voffB); PG8_STAGE(PG8_SA(1, 0), cA + kstep, voffA); PG8_STAGE(PG8_SB(1, 1), cB + hstepB + kstep, voffB);
        PG8_WAIT_V(6); PG8_BAR;
    } else {
        PG8_STAGE(PG8_SB(0, 0), cB, voffB); PG8_STAGE(PG8_SA(0, 0), cA, voffA); PG8_STAGE(PG8_SB(0, 1), cB + hstepB, voffB); PG8_STAGE(PG8_SA(0, 1), cA + hstepA, voffA);
        if (wr == 1) PG8_BAR;
        PG8_WAIT_V(4); PG8_BAR;
        PG8_STAGE(PG8_SB(1, 0), cB + kstep, voffB); PG8_STAGE(PG8_SA(1, 0), cA + kstep, voffA); PG8_STAGE(PG8_SB(1, 1), cB + hstepB + kstep, voffB);
        PG8_WAIT_V(6); PG8_BAR;
    }
    for (;;) {
        const bool has_next = S.next(ui + 1, nxt);
        const char* nA = has_next ? S.a_ptr(nxt) : cA; const char* nB = has_next ? S.b_ptr(nxt) : cB;
        for (int t = 0; t < nt; t += 2) {
            const bool last = (t == nt - 2);
            const char* a1 = cA + (size_t)(t + 1) * kstep;
            const char* a2 = last ? nA : cA + (size_t)(t + 2) * kstep; const char* b2 = last ? nB : cB + (size_t)(t + 2) * kstep;
            const char* a3 = a2 + kstep; const char* b3 = b2 + kstep;
            if (last && has_next) S.a_ready(nxt);
            if constexpr (SP2) {
            PG8_LDB(B0, 0, 0); PG8_LDB(B1, 0, 1); PG8_SCHED; PG8_LDA(At, 0, 0); PG8_STAGE(PG8_SA(1, 1), a1 + hstepA, voffA);
            PG8_WAIT_V(8); PG8_WAIT_L(0); PG8_BAR; PG8_MMA(0, 0, At, B0); PG8_MMA(0, 1, At, B1); PG8_BAR; PG8_SCHED;
            PG8_LDA(At, 0, 1); PG8_STAGE(PG8_SB(0, 0), b2, voffB); PG8_STAGE(PG8_SB(0, 1), b2 + hstepB, voffB); PG8_STAGE(PG8_SA(0, 0), a2, voffA);
            PG8_WAIT_V(8); PG8_WAIT_L(0); PG8_BAR; PG8_MMA(1, 0, At, B0); PG8_MMA(1, 1, At, B1); PG8_BAR; PG8_SCHED;
            PG8_LDB(B0, 1, 0); PG8_LDB(B1, 1, 1); PG8_SCHED; PG8_LDA(At, 1, 0); PG8_STAGE(PG8_SA(0, 1), a2 + hstepA, voffA);
            PG8_WAIT_V(8); PG8_WAIT_L(0); PG8_BAR; PG8_MMA(0, 0, At, B0); PG8_MMA(0, 1, At, B1); PG8_BAR; PG8_SCHED;
            PG8_LDA(At, 1, 1); PG8_STAGE(PG8_SB(1, 0), b3, voffB); PG8_STAGE(PG8_SB(1, 1), b3 + hstepB, voffB); PG8_STAGE(PG8_SA(1, 0), a3, voffA);
            PG8_WAIT_V(8); PG8_WAIT_L(0); PG8_BAR; PG8_MMA(1, 0, At, B0); PG8_MMA(1, 1, At, B1); PG8_BAR; PG8_SCHED;
            } else {
            PG8_LDB(B0, 0, 0); PG8_SCHED; PG8_LDA(At, 0, 0); PG8_STAGE(PG8_SA(1, 1), a1 + hstepA, voffA);
            PG8_WAIT_L(8); PG8_BAR; PG8_WAIT_L(0); PG8_MMA(0, 0, At, B0); PG8_BAR; PG8_SCHED;
            PG8_LDB(B1, 0, 1); PG8_STAGE(PG8_SB(0, 0), b2, voffB);
            PG8_BAR; PG8_WAIT_L(0); PG8_MMA(0, 1, At, B1); PG8_BAR;
            PG8_LDA(At, 0, 1); PG8_STAGE(PG8_SA(0, 0), a2, voffA);
            PG8_BAR; PG8_WAIT_L(0); PG8_MMA(1, 0, At, B0); PG8_BAR; PG8_SCHED;
            PG8_STAGE(PG8_SB(0, 1), b2 + hstepB, voffB);
            PG8_WAIT_V(6); PG8_BAR; PG8_MMA(1, 1, At, B1); PG8_BAR;
            PG8_LDB(B0, 1, 0); PG8_SCHED; PG8_LDA(At, 1, 0); PG8_STAGE(PG8_SA(0, 1), a2 + hstepA, voffA);
            PG8_WAIT_L(8); PG8_BAR; PG8_WAIT_L(0); PG8_MMA(0, 0, At, B0); PG8_BAR; PG8_SCHED;
            PG8_LDB(B1, 1, 1); PG8_STAGE(PG8_SB(1, 0), b3, voffB);
            PG8_BAR; PG8_WAIT_L(0); PG8_MMA(0, 1, At, B1); PG8_BAR;
            PG8_LDA(At, 1, 1); PG8_STAGE(PG8_SA(1, 0), a3, voffA);
            PG8_BAR; PG8_WAIT_L(0); PG8_MMA(1, 0, At, B0); PG8_BAR; PG8_SCHED;
            PG8_STAGE(PG8_SB(1, 1), b3 + hstepB, voffB);
            PG8_WAIT_V(6); PG8_BAR; PG8_MMA(1, 1, At, B1); PG8_BAR;
            }
        }
        if constexpr (ALIGN_EPI) { if (wr == 0) PG8_BAR; }
        if constexpr (!Epi::AFTER_DRAIN) { E(acc, cur, wr, wc, fr, fq); S.done(cur); }
        if (!has_next) break;
#pragma unroll
        for (int a = 0; a < 2; ++a)
#pragma unroll
            for (int b = 0; b < 2; ++b)
#pragma unroll
                for (int m = 0; m < 4; ++m)
#pragma unroll
                    for (int n = 0; n < 2; ++n) acc[a][b][m][n] = (f32x4){0.f, 0.f, 0.f, 0.f};
        cur = nxt; cA = nA; cB = nB; ++ui;
        if constexpr (ALIGN_EPI) { if (wr == 1) PG8_BAR; }
    }
    PG8_WAIT_V(0);
    if constexpr (!ALIGN_EPI) { if (wr == 0) PG8_BAR; }
    PG8_BAR;
    if constexpr (Epi::AFTER_DRAIN) { E.fused(acc, cur, wr, wc, fr, fq, lds, wid, lane); S.done(cur); }
#undef PG8_SA
#undef PG8_SB
#undef PG8_STAGE
#undef PG8_LDA
#undef PG8_LDB
#undef PG8_MMA
#undef PG8_WAIT_V
#undef PG8_WAIT_L
#undef PG8_BAR
#undef PG8_SCHED
}
}

namespace att {
typedef unsigned short bf16;
typedef short bf16x8 __attribute__((ext_vector_type(8)));
typedef short s16x4 __attribute__((ext_vector_type(4)));
typedef float f32x16 __attribute__((ext_vector_type(16)));
typedef float f32x4 __attribute__((ext_vector_type(4)));
typedef unsigned u32x4 __attribute__((ext_vector_type(4)));
constexpr int D = 128, NW = 8, QBLK = 32, KVBLK = 64, QB = NW * QBLK;
constexpr int QP = 1024, KP = 1024, OP = 2048, GPI = 1024;
constexpr int SHM_V = KVBLK * D * 2, SHM_K = KVBLK * D * 2;
constexpr int LDS_BYTES = 2 * SHM_V + 2 * SHM_K + NW * 64 * 4;
constexpr float SCALE = 0.08838834764831845f, THR = 8.f;
template <class A, class Bt> struct same_t { static constexpr bool v = false; };
template <class A> struct same_t<A, A> { static constexpr bool v = true; };

#define KSWZ(row, colB) ((row) * 256 + ((colB) ^ (((row) & 7) << 4)))
#define SBAR() __builtin_amdgcn_sched_barrier(0)
__device__ __forceinline__ int v_st(int k, int c) { const int kk = (k & ~0xC) | ((k & 4) << 1) | ((k & 8) >> 1); return ((kk >> 3) * 4 + (c >> 5)) * 512 + ((kk & 7) * 32 + (c & 31)) * 2; }
__device__ __forceinline__ int v_rd_base(int lane) { return ((lane & 3) << 3) | (((lane >> 2) & 3) << 6) | (((lane >> 4) & 1) << 5) | (((lane >> 5) & 1) << 8); }
constexpr int v_rd_off(int d0, int ks, int half) { return d0 * 512 + ks * 4096 + half * 2048; }
__device__ __forceinline__ int crow(int r, int hi) { return (r & 3) + 8 * (r >> 2) + 4 * hi; }
__device__ __forceinline__ unsigned cvtpk(float lo, float hi) { unsigned r; asm volatile("v_cvt_pk_bf16_f32 %0, %1, %2" : "=v"(r) : "v"(lo), "v"(hi)); return r; }
__device__ __forceinline__ bf16x8 pack8(f32x4 a, f32x4 b) { u32x4 w = {cvtpk(a[0], a[1]), cvtpk(a[2], a[3]), cvtpk(b[0], b[1]), cvtpk(b[2], b[3])}; return *reinterpret_cast<bf16x8*>(&w); }
__device__ __forceinline__ bf16x8 ld8h(const bf16* p) { return *reinterpret_cast<const bf16x8*>(p); }

__device__ __forceinline__ void mask_tile(f32x16& p0, f32x16& p1, int dq) {
    const float NEG = -__builtin_inff();
#pragma unroll
    for (int r = 0; r < 16; ++r) {
        const int c = (r & 3) + 8 * (r >> 2);
        if (dq - c < 0) p0[r] = NEG;
        if (dq - c - 32 < 0) p1[r] = NEG;
    }
}
__device__ __forceinline__ void partialSM(f32x16& p0, f32x16& p1, float& m_reg, float& mn, float& alpha) {
    float pmax = p0[0]; for (int r = 1; r < 16; ++r) pmax = fmaxf(pmax, p0[r]); for (int r = 0; r < 16; ++r) pmax = fmaxf(pmax, p1[r]);
    { auto rr = __builtin_amdgcn_permlane32_swap(__float_as_uint(pmax), __float_as_uint(pmax), false, false);
      pmax = fmaxf(__uint_as_float(rr[0]), __uint_as_float(rr[1])); }
    constexpr float C2 = 1.4426950408889634f * SCALE;
    if (__builtin_expect(__all((pmax - m_reg) * SCALE <= THR), 1)) { mn = m_reg; alpha = 1.f; }
    else { mn = fmaxf(m_reg, pmax); alpha = __builtin_amdgcn_exp2f((m_reg - mn) * C2); m_reg = mn; }
    const float mnL = -mn * C2;
    for (int r = 0; r < 16; ++r) p0[r] = fmaf(p0[r], C2, mnL); for (int r = 0; r < 16; ++r) p1[r] = fmaf(p1[r], C2, mnL);
    for (int r = 0; r < 16; ++r) p0[r] = __builtin_amdgcn_exp2f(p0[r]);
}
__device__ __forceinline__ void finishSM(f32x16& p0, f32x16& p1, float alpha, float& l_reg, bf16x8& pa0, bf16x8& pa1, bf16x8& pa2, bf16x8& pa3) {
    for (int r = 0; r < 16; ++r) p1[r] = __builtin_amdgcn_exp2f(p1[r]);
    float ps = 0; for (int r = 0; r < 16; ++r) ps += p0[r]; for (int r = 0; r < 16; ++r) ps += p1[r];
    { auto rr = __builtin_amdgcn_permlane32_swap(__float_as_uint(ps), __float_as_uint(ps), false, false);
      ps = __uint_as_float(rr[0]) + __uint_as_float(rr[1]); }
    l_reg = l_reg * alpha + ps;
#define PK4(P, B_, OUT) do { unsigned a0 = cvtpk(P[B_+0], P[B_+1]), a1 = cvtpk(P[B_+2], P[B_+3]);                          \
        unsigned b0 = cvtpk(P[B_+4], P[B_+5]), b1 = cvtpk(P[B_+6], P[B_+7]);                                             \
        auto r0 = __builtin_amdgcn_permlane32_swap(a0, b0, false, false); auto r1 = __builtin_amdgcn_permlane32_swap(a1, b1, false, false); \
        u32x4 w = {r0[0], r1[0], r0[1], r1[1]}; OUT = *reinterpret_cast<bf16x8*>(&w); } while (0)
    PK4(p0, 0, pa0); PK4(p0, 8, pa1); PK4(p1, 0, pa2); PK4(p1, 8, pa3);
#undef PK4
}
__device__ __forceinline__ void loadck(f32x16& p0, f32x16& p1, const float* CK, int off  ) { const float* ckt = CK + off;
#pragma unroll
    for (int g = 0; g < 4; ++g) { const f32x4 a = *(const f32x4*)(ckt + 8 * g), b = *(const f32x4*)(ckt + 32 + 8 * g);
        p0[4 * g] = a[0]; p0[4 * g + 1] = a[1]; p0[4 * g + 2] = a[2]; p0[4 * g + 3] = a[3];
        p1[4 * g] = b[0]; p1[4 * g + 1] = b[1]; p1[4 * g + 2] = b[2]; p1[4 * g + 3] = b[3]; }
}
template <int KB, bool SK>
__device__ __forceinline__ void qkt(f32x16& p0, f32x16& p1, const char* K_lds, int r32, int hi, const bf16x8* qr, float cqv, bool act) {
    if (SK && !act) { const float NEG = -__builtin_inff();
#pragma unroll
        for (int r = 0; r < 16; ++r) { p0[r] = NEG; p1[r] = NEG; } return; }
#pragma unroll
    for (int r = 0; r < 16; ++r) { p0[r] = cqv - p0[r]; p1[r] = cqv - p1[r]; }
    const char* kb[4];
#pragma unroll
    for (int dd = 0; dd < 4; ++dd) kb[dd] = K_lds + KB * SHM_K + KSWZ(r32, (dd * 16 + hi * 8) * 2);
#pragma unroll
    for (int d0 = 0; d0 < 8; ++d0) { const char* a = kb[d0 & 3] + (d0 >> 2) * 128;
        bf16x8 b0 = *reinterpret_cast<const bf16x8*>(a);
        bf16x8 b1 = *reinterpret_cast<const bf16x8*>(a + 32 * 256);
        p0 = __builtin_amdgcn_mfma_f32_32x32x16_bf16(b0, qr[d0], p0, 0, 0, 0);
        p1 = __builtin_amdgcn_mfma_f32_32x32x16_bf16(b1, qr[d0], p1, 0, 0, 0);
        if (d0 == 3) SBAR(); }
}
template <int VB, int ND>
__device__ __forceinline__ void pv_tile(f32x16* o, int vb0, bf16x8 pa0, bf16x8 pa1, bf16x8 pa2, bf16x8 pa3) {
#define TRRD(dst, off) asm volatile("ds_read_b64_tr_b16 %0, %1 offset:%2" : "=&v"(dst) : "v"(vb0), "i"(off) : "memory")
#define PV_D0(d0) do { s16x4 l0, l1, l2, l3, h0, h1, h2, h3; constexpr int b_ = VB * SHM_V + v_rd_off(d0, 0, 0); \
        TRRD(l0, b_); TRRD(h0, b_ + 2048); TRRD(l1, b_ + 4096); TRRD(h1, b_ + 6144); TRRD(l2, b_ + 8192); TRRD(h2, b_ + 10240); TRRD(l3, b_ + 12288); TRRD(h3, b_ + 14336); \
        asm volatile("s_waitcnt lgkmcnt(0)" ::: "memory"); SBAR();   \
        o[d0] = __builtin_amdgcn_mfma_f32_32x32x16_bf16((bf16x8){l0[0], l0[1], l0[2], l0[3], h0[0], h0[1], h0[2], h0[3]}, pa0, o[d0], 0, 0, 0);   \
        o[d0] = __builtin_amdgcn_mfma_f32_32x32x16_bf16((bf16x8){l1[0], l1[1], l1[2], l1[3], h1[0], h1[1], h1[2], h1[3]}, pa1, o[d0], 0, 0, 0);   \
        o[d0] = __builtin_amdgcn_mfma_f32_32x32x16_bf16((bf16x8){l2[0], l2[1], l2[2], l2[3], h2[0], h2[1], h2[2], h2[3]}, pa2, o[d0], 0, 0, 0);   \
        o[d0] = __builtin_amdgcn_mfma_f32_32x32x16_bf16((bf16x8){l3[0], l3[1], l3[2], l3[3], h3[0], h3[1], h3[2], h3[3]}, pa3, o[d0], 0, 0, 0); } while (0)
    PV_D0(0); if constexpr (ND == 4) { PV_D0(1); PV_D0(2); PV_D0(3); }
#undef PV_D0
#undef TRRD
}

template <class TKV> struct BlockRef { const bf16* Q; const TKV* K; const TKV* V; const TKV* Kn; const TKV* Vn; bf16* O; const bf16* G; const float* CQ; const float* CK; int np, P0, jhi; };
struct Seam { bf16x8 qr[8]; bf16x8 st_v0, st_v1, st_k0, st_k1; f32x4 sf0, sf1, sf2, sf3, sv0, sv1, sv2, sv3; };

#define TBASE(ref, base, basen, k0, half) ((F32 && (k0) >= (ref).np) ? (const char*)(basen) : (const char*)((base) + (size_t)((k0) + 32 * (half)) * KP))
#define VMW() asm volatile("s_waitcnt vmcnt(0)" ::: "memory")
#define VMWN(n) asm volatile("s_waitcnt vmcnt(%0)" :: "i"(n) : "memory")
#define SLOAD_H(ref, k0) do { S.st_v0 = *(const bf16x8*)(TBASE(ref, (ref).V, (ref).Vn, k0, 0) + rofs); S.st_v1 = *(const bf16x8*)(TBASE(ref, (ref).V, (ref).Vn, k0, 1) + rofs);              \
                              S.st_k0 = *(const bf16x8*)(TBASE(ref, (ref).K, (ref).Kn, k0, 0) + rofs); S.st_k1 = *(const bf16x8*)(TBASE(ref, (ref).K, (ref).Kn, k0, 1) + rofs); } while (0)
#define SWRITE_HK(bf) do { *(bf16x8*)(K_lds + (bf) * SHM_K + kws) = S.st_k0; *(bf16x8*)(K_lds + (bf) * SHM_K + kws + 32 * 256) = S.st_k1; } while (0)
#define SWRITE_HV(bf) do { *(bf16x8*)(V_lds + (bf) * SHM_V + vst0) = S.st_v0; *(bf16x8*)(V_lds + (bf) * SHM_V + vst0 + 8192) = S.st_v1; } while (0)
#define SWRITE_H(bf) do { SWRITE_HV(bf); SWRITE_HK(bf); } while (0)
#define SLOAD_FK(ref, k0) do { const char* r0_ = TBASE(ref, (ref).K, (ref).Kn, k0, 0) + rofs; const char* r1_ = TBASE(ref, (ref).K, (ref).Kn, k0, 1) + rofs; \
                               S.sf0 = *(const f32x4*)r0_; S.sf1 = *(const f32x4*)(r0_ + 16); S.sf2 = *(const f32x4*)r1_; S.sf3 = *(const f32x4*)(r1_ + 16); } while (0)
#define SLOAD_FV(ref, k0) do { const char* r0_ = TBASE(ref, (ref).V, (ref).Vn, k0, 0) + rofs; const char* r1_ = TBASE(ref, (ref).V, (ref).Vn, k0, 1) + rofs; \
                               S.sv0 = *(const f32x4*)r0_; S.sv1 = *(const f32x4*)(r0_ + 16); S.sv2 = *(const f32x4*)r1_; S.sv3 = *(const f32x4*)(r1_ + 16); } while (0)
#define SWRITE_KF(bf) do { *(bf16x8*)(K_lds + (bf) * SHM_K + kws) = pack8(S.sf0, S.sf1); *(bf16x8*)(K_lds + (bf) * SHM_K + kws + 32 * 256) = pack8(S.sf2, S.sf3); } while (0)
#define SWRITE_VF(bf) do { *(bf16x8*)(V_lds + (bf) * SHM_V + vst0) = pack8(S.sv0, S.sv1); *(bf16x8*)(V_lds + (bf) * SHM_V + vst0 + 8192) = pack8(S.sv2, S.sv3); } while (0)

template <class TKV, bool SOLO>
__device__ __forceinline__ void fox_prime(const BlockRef<TKV>& cur, char* lds, Seam& S) {
    constexpr bool F32 = same_t<TKV, float>::v;
    int tid = threadIdx.x; asm volatile("" : "+v"(tid));
    const int wid = __builtin_amdgcn_readfirstlane(tid >> 6), lane = tid & 63, r32 = lane & 31, hi = lane >> 5;
    const int wq = SOLO ? 0 : wid;
    const int sr = tid >> 4, sc = (tid & 15) * 8, kws = KSWZ(sr, sc * 2); char* K_lds = lds + 2 * SHM_V;
    const unsigned rofs = (unsigned)(sr * KP + sc) * (unsigned)sizeof(TKV);
    constexpr int kb0 = 0;
#pragma unroll
    for (int d0 = 0; d0 < 8; ++d0) S.qr[d0] = ld8h(cur.Q + (size_t)(wq * QBLK + r32) * QP + d0 * 16 + hi * 8);
    if constexpr (F32) { SLOAD_FK(cur, kb0); SLOAD_FV(cur, kb0); SBAR(); SWRITE_KF(0); SBAR(); }
    else { SLOAD_H(cur, kb0); VMW(); SWRITE_HK(0); }
    __syncthreads();
}
template <class TKV, bool SOLO>
__device__ __forceinline__ void fox_block(const BlockRef<TKV>& cur, const BlockRef<TKV>& nxt, char* lds, Seam& S) {
    constexpr bool F32 = same_t<TKV, float>::v;
    constexpr bool SK = SOLO;
    int tid = threadIdx.x; asm volatile("" : "+v"(tid));
    const int wid = __builtin_amdgcn_readfirstlane(tid >> 6), lane = tid & 63, r32 = lane & 31, hi = lane >> 5;
    const int wq = SOLO ? 0 : wid;
    const bool wact = !SOLO || wid < 4;
    constexpr int j_lo = 0, kbn = 0;
    const int NT = cur.jhi;
    const int qlo = cur.P0 + wq * QBLK, qm = qlo + r32 - 4 * hi;
    char* V_lds = lds; char* K_lds = lds + 2 * SHM_V;
    constexpr int ND = SOLO ? 1 : 4;
    float m_reg = -1e30f, l_reg = 0; f32x16 o[ND] = {};
    const int sr = tid >> 4, sc = (tid & 15) * 8, vst0 = v_st(sr, sc), kws = KSWZ(sr, sc * 2);
    const unsigned rofs = (unsigned)(sr * KP + sc) * (unsigned)sizeof(TKV);
    const int vb0 = (int)(uintptr_t)V_lds + v_rd_base(lane) + (SOLO ? (wid & 3) * 512 : 0);
    const float cqv = cur.CQ[wq * QBLK + r32];
#define RESC(a) do { if (__any((a) < 1.f)) { for (int d_ = 0; d_ < ND; ++d_) for (int r = 0; r < 16; ++r) o[d_][r] *= (a); } } while (0)
#define KBASE(t) ((j_lo + (t)) * KVBLK)
#define MASKT(P0_, P1_, t) do { const int kb_ = KBASE(t); if (wact && kb_ + KVBLK - 1 > qlo) mask_tile(P0_, P1_, qm - kb_); } while (0)
#define LOADCK(P0_, P1_, t) do { if (wact) loadck(P0_, P1_, cur.CK, KBASE(t) + 4 * hi); } while (0)
    constexpr int NQL = 8;
#define SEAM_K0() do { if constexpr (F32) { SWRITE_KF(0); } else { VMWN(NQL); SWRITE_HK(0); } SBAR(); } while (0)
    f32x16 pA0, pA1, pB0, pB1; float mnA, mnB, alA, alB; bf16x8 pa0, pa1, pa2, pa3;
    LOADCK(pA0, pA1, 0);
    if constexpr (F32) { SWRITE_VF(0); SBAR(); } else { SWRITE_HV(0); SBAR(); }
    if (NT > 1) { if constexpr (F32) { SLOAD_FK(cur, KBASE(1)); SLOAD_FV(cur, KBASE(1)); } else SLOAD_H(cur, KBASE(1)); }
    SBAR(); qkt<0, SK>(pA0, pA1, K_lds, r32, hi, S.qr, cqv, wact);
    if (NT > 1) { LOADCK(pB0, pB1, 1); SBAR(); }
    if constexpr (F32) { if (NT > 1) { SWRITE_KF(1); SBAR(); if (NT > 2) SLOAD_FK(cur, KBASE(2)); SBAR(); } }
    if (wact) { MASKT(pA0, pA1, 0); partialSM(pA0, pA1, m_reg, mnA, alA); }
    if (NT > 1) { if constexpr (F32) { SWRITE_VF(1); SBAR(); if (NT > 2) SLOAD_FV(cur, KBASE(2)); } else { VMW(); SWRITE_H(1); } }
    __syncthreads();
#define HALF_STEP(PX0, PX1, mnX, alX, PY0, PY1, alY, t, KB, VB, SB) do {                                                      \
        SBAR(); qkt<KB, SK>(PX0, PX1, K_lds, r32, hi, S.qr, cqv, wact);                                                       \
        if (wact) finishSM(PY0, PY1, alY, l_reg, pa0, pa1, pa2, pa3); SBAR();                                                 \
        if ((t) + 1 < NT) { if constexpr (F32) { SWRITE_KF(SB); SBAR(); LOADCK(PY0, PY1, (t) + 1); SBAR(); if ((t) + 2 < NT) SLOAD_FK(cur, KBASE((t) + 2)); SBAR(); } \
                            else { SLOAD_H(cur, KBASE((t) + 1)); SBAR(); LOADCK(PY0, PY1, (t) + 1); SBAR(); } }               \
        if (wact) { pv_tile<VB, ND>(o, vb0, pa0, pa1, pa2, pa3); MASKT(PX0, PX1, (t)); partialSM(PX0, PX1, m_reg, mnX, alX); } \
        __syncthreads();                                                                                                      \
        if ((t) + 1 < NT) { if constexpr (F32) { SWRITE_VF(SB); SBAR(); if ((t) + 2 < NT) SLOAD_FV(cur, KBASE((t) + 2)); } \
                            else { VMW(); SWRITE_H(SB); } }                                                                   \
        if (wact) RESC(alX); __syncthreads(); } while (0)
    for (int t = 1; t + 1 < NT; t += 2) {
        HALF_STEP(pB0, pB1, mnB, alB, pA0, pA1, alA, t, 1, 0, 0);
        HALF_STEP(pA0, pA1, mnA, alA, pB0, pB1, alB, t + 1, 0, 1, 1);
    }
    const bool even = (NT & 1) == 0;
    if (even) { SBAR(); qkt<1, SK>(pB0, pB1, K_lds, r32, hi, S.qr, cqv, wact); SBAR(); }
    if constexpr (F32) { SLOAD_FK(nxt, kbn); SLOAD_FV(nxt, kbn); SBAR(); } else { SLOAD_H(nxt, kbn); SBAR(); }
    { const int wqn = SOLO ? 0 : wid;
#pragma unroll
      for (int d0 = 0; d0 < 8; ++d0) S.qr[d0] = ld8h(nxt.Q + (size_t)(wqn * QBLK + r32) * QP + d0 * 16 + hi * 8); }
    SBAR();
    if (wact) { finishSM(pA0, pA1, alA, l_reg, pa0, pa1, pa2, pa3); SBAR(); pv_tile<0, ND>(o, vb0, pa0, pa1, pa2, pa3); }
    if (even) { if (wact) { MASKT(pB0, pB1, NT - 1); partialSM(pB0, pB1, m_reg, mnB, alB); } __syncthreads();
        if (wact) { RESC(alB); finishSM(pB0, pB1, alB, l_reg, pa0, pa1, pa2, pa3); SBAR(); pv_tile<1, ND>(o, vb0, pa0, pa1, pa2, pa3); } }
    SBAR(); SEAM_K0();
    if (!SOLO || wid < 4) {
        const float inv = __builtin_amdgcn_rcpf(l_reg);
        const int cb = SOLO ? (wid & 3) * 32 : 0;
        bf16* Ow = cur.O + (size_t)(wq * QBLK + r32) * OP + 4 * hi + cb; const bf16* Gw = cur.G + (size_t)(wq * QBLK + r32) * GPI + 4 * hi + cb;
        uint2 gt[ND][4];
#pragma unroll
        for (int d0 = 0; d0 < ND; ++d0)
#pragma unroll
            for (int g = 0; g < 4; ++g) gt[d0][g] = *(const uint2*)(Gw + d0 * 32 + 8 * g);
#pragma unroll
        for (int d0 = 0; d0 < ND; ++d0)
#pragma unroll
            for (int g = 0; g < 4; ++g) { const uint2 t = gt[d0][g];
                uint2 w; w.x = cvtpk(o[d0][4 * g] * inv * __uint_as_float(t.x << 16), o[d0][4 * g + 1] * inv * __uint_as_float(t.x & 0xffff0000u));
                w.y = cvtpk(o[d0][4 * g + 2] * inv * __uint_as_float(t.y << 16), o[d0][4 * g + 3] * inv * __uint_as_float(t.y & 0xffff0000u));
                *(uint2*)(Ow + d0 * 32 + 8 * g) = w; }
    }
    __syncthreads();
#undef RESC
#undef KBASE
#undef MASKT
#undef LOADCK
#undef SEAM_K0
#undef HALF_STEP
}
#undef TBASE
#undef VMW
#undef VMWN
#undef SLOAD_H
#undef SWRITE_HK
#undef SWRITE_HV
#undef SWRITE_H
#undef SLOAD_FK
#undef SLOAD_FV
#undef SWRITE_KF
#undef SWRITE_VF
}

constexpr int DM = 2048, NB = 4, SEQ = 8192, DECB = 32, DECS = 32, PAST = 4096, NH = 8, HD = 128, DATT = 1024, DSSM = 1024, NG = 64, NST = 64, DPLE = 256;
constexpr int MP = NB * SEQ, MS = DECB * DECS, MT = MP + MS;
constexpr int DIN = 6152, OFF_F = 3072;
constexpr int NIN = 6144;
constexpr int CHUNK = 32, NCH = MT / CHUNK, UHROWS = NCH, UHLD = 640;
constexpr int NSSM_ITEMS = NG * 5;
constexpr int CSLD = 4160;
constexpr float EPS = 1e-6f;
constexpr size_t O_YP = 0, O_YS = O_YP + (size_t)MP * DM, O_KP = O_YS + (size_t)MS * DM, O_VP = O_KP + (size_t)MP * DATT, O_LFP = O_VP + (size_t)MP * DATT,
                 O_SRP = O_LFP + (size_t)MP * NH, O_SIP = O_SRP + NB * NG * NST, O_KS = O_SIP + NB * NG * NST, O_VS = O_KS + (size_t)MS * DATT, O_LFS = O_VS + (size_t)MS * DATT,
                 O_SRS = O_LFS + (size_t)MS * NH, O_SIS = O_SRS + DECB * NG * NST, O_END = O_SIS + DECB * NG * NST;
constexpr size_t MiB = 1u << 20;
constexpr size_t WS_CTL = 0, CTL_ZERO_BYTES = 1 * MiB;
constexpr size_t WS_WIN_T = 1 * MiB, WS_WGLU_T = 25 * MiB, WS_WOUT_T = 27 * MiB, WS_WPE_T = 35 * MiB, WS_WPG_T = 36 * MiB;
constexpr size_t WS_MW_T = 44 * MiB, WS_BP_T = 84 * MiB, WS_A32 = 100 * MiB, WS_LOGF = 101 * MiB, WS_CP = 103 * MiB, WS_CS = 104 * MiB;
constexpr size_t WS_ESS = 109 * MiB, WS_H2SS = 114 * MiB, WS_RSTDE = 119 * MiB;
constexpr size_t WS_XN = 120 * MiB, WS_PB = 252 * MiB, WS_Q = 270 * MiB, WS_K = 336 * MiB, WS_V = 402 * MiB, WS_SGA = 468 * MiB, WS_SGS = 534 * MiB;
constexpr size_t WS_UH = 600 * MiB, WS_SBUF = 684 * MiB, WS_YACT = 724 * MiB, WS_MIXED = 790 * MiB, WS_HB = 922 * MiB, WS_E = 1054 * MiB, WS_QSS = 1186 * MiB, WS_KSS = 1191 * MiB, WS_END = 1196 * MiB;
constexpr size_t WS_GP = 1200 * MiB;
static_assert(WS_LOGF + (size_t)MT * 8 * 4 <= WS_CP && WS_CS + (size_t)DECB * NH * CSLD * 4 <= WS_ESS && WS_ESS + (size_t)MT * 32 * 4 <= WS_H2SS && WS_H2SS + (size_t)MT * 32 * 4 <= WS_RSTDE, "ws map a");
static_assert(WS_XN + (size_t)MT * DM * 2 <= WS_PB && WS_PB + (size_t)MT * DPLE * 2 <= WS_Q && WS_Q + (size_t)MT * DATT * 2 <= WS_K && WS_UH + (size_t)(NG * UHROWS + 256) * UHLD * 2 <= WS_SBUF, "ws map b");
static_assert(WS_SBUF + (size_t)NSSM_ITEMS * 256 * 128 * 4 <= WS_YACT && WS_YACT + (size_t)MT * DSSM * 2 <= WS_MIXED && WS_MIXED + (size_t)MT * DM * 2 <= WS_HB && WS_E + (size_t)MT * DM * 2 <= WS_QSS && WS_QSS + (size_t)MT * 32 * 4 <= WS_KSS && WS_KSS + (size_t)MT * 32 * 4 <= WS_END, "ws map c");
constexpr int CW_TMO = 0, CW_BAR = 4096, CW_KCM = 8192;

constexpr int NWAVES = 8, NTHR = 512;
constexpr int RING_OFF = 0, RING_BYTES = 131072, LDSCTL_OFF = RING_BYTES, MISC_OFF = LDSCTL_OFF + 320, LDS_BYTES = 147456;

#define GAS __attribute__((address_space(1)))
#define LAS __attribute__((address_space(3)))
typedef unsigned short bf16;
typedef unsigned v4u __attribute__((ext_vector_type(4)));
typedef unsigned v2u __attribute__((ext_vector_type(2)));
typedef float f32x4 __attribute__((ext_vector_type(4)));
typedef float f32x2 __attribute__((ext_vector_type(2)));
#define LDS_WAIT() asm volatile("s_waitcnt lgkmcnt(0)" ::: "memory")
#define VM_WAIT() asm volatile("s_waitcnt vmcnt(0)" ::: "memory")
__device__ __forceinline__ unsigned f2bf(float f) { unsigned u = __builtin_bit_cast(unsigned, f); return (u + 0x7fffu + ((u >> 16) & 1u)) >> 16; }
__device__ __forceinline__ unsigned pk2(float lo, float hi) { return f2bf(lo) | (f2bf(hi) << 16); }
__device__ __forceinline__ float wave_sum(float v) {
#pragma unroll
    for (int o = 1; o < 64; o <<= 1) v += __shfl_xor(v, o);
    return v;
}

#define XB_TMO      128
#define XB_XCNT(j)  (256  + 64 * (j))
#define XB_XSUB(j)  (1280 + 64 * (j))
#define XB_XGEN(j)  (2304 + 64 * (j))
#define XB_TOP      3328
#define XB_TOPGEN   3392
#define XCD_BAR_WORDS 3456
#define XB_SPIN_CAP (1u << 22)
__device__ __forceinline__ unsigned xb_ld(unsigned* p)              { return __hip_atomic_load(p, __ATOMIC_RELAXED, __HIP_MEMORY_SCOPE_AGENT); }
__device__ __forceinline__ unsigned xb_add(unsigned* p, unsigned v) { return __hip_atomic_fetch_add(p, v, __ATOMIC_RELAXED, __HIP_MEMORY_SCOPE_AGENT); }
__device__ __forceinline__ unsigned xb_xcc_id() { return (unsigned)__builtin_amdgcn_s_getreg((3 << 11) | 20) & 0xFu; }
#define XB_SPIN(cond, bar) do { unsigned _sp = 0; while (cond) { __builtin_amdgcn_s_sleep(1); \
    if ((++_sp & 255u) == 0u) { if (xb_ld(&(bar)[XB_TMO])) break; if (_sp > XB_SPIN_CAP) { atomicAdd(&(bar)[XB_TMO], 1u); break; } } } } while (0)
struct XcdBarrier { unsigned* bar; unsigned x; volatile LAS unsigned* st; };
__device__ __forceinline__ XcdBarrier xcd_barrier_post(unsigned* bar, volatile LAS unsigned* st) {
    XcdBarrier b; b.bar = bar; b.x = xb_xcc_id(); b.st = st;
    if (threadIdx.x == 0) (void)xb_add(&bar[XB_XCNT(b.x)], 1u);
    return b;
}
__device__ __forceinline__ void xcd_barrier_complete(unsigned* bar, unsigned x, unsigned& nloc, unsigned& nx) {
    const unsigned G = gridDim.x * gridDim.y * gridDim.z;
    unsigned sum, cnt, mine, sp = 0u;
    for (;;) {
        sum = 0u; cnt = 0u; mine = 0u;
#pragma unroll
        for (unsigned j = 0; j < 16; ++j) { const unsigned c = xb_ld(&bar[XB_XCNT(j)]); sum += c; cnt += (c > 0u) ? 1u : 0u; mine = (j == x) ? c : mine; }
        if (sum == G) break;
        __builtin_amdgcn_s_sleep(1);
        if ((++sp & 255u) == 0u) { if (xb_ld(&bar[XB_TMO])) break; if (sp > XB_SPIN_CAP) { atomicAdd(&bar[XB_TMO], 1u); break; } }
    }
    nloc = mine > 0u ? mine : 1u; nx = cnt > 0u ? cnt : 1u;
}
__device__ __forceinline__ void xcd_barrier(const XcdBarrier& b) {
    asm volatile("s_waitcnt vmcnt(0)" ::: "memory");
    __syncthreads();
    if (threadIdx.x == 0) {
        unsigned* bar = b.bar;
        __builtin_amdgcn_s_waitcnt(0);
        unsigned nloc = b.st[0], nx = b.st[1];
        if (nloc == 0u) { xcd_barrier_complete(bar, b.x, nloc, nx); b.st[0] = nloc; b.st[1] = nx; }
        const unsigned old = xb_add(&bar[XB_XSUB(b.x)], 1u);
        const unsigned gen = old / nloc;
        if (old + 1u == (gen + 1u) * nloc) {
            __builtin_amdgcn_fence(__ATOMIC_RELEASE, "agent");
            asm volatile("s_waitcnt vmcnt(0)" ::: "memory");
            const unsigned og = xb_add(&bar[XB_TOP], 1u);
            const unsigned tg = og / nx;
            if (og + 1u == (tg + 1u) * nx) xb_add(&bar[XB_TOPGEN], 1u);
            else XB_SPIN(xb_ld(&bar[XB_TOPGEN]) == tg, bar);
            __builtin_amdgcn_fence(__ATOMIC_ACQUIRE, "agent");
            xb_add(&bar[XB_XGEN(b.x)], 1u);
            asm volatile("s_waitcnt vmcnt(0)" ::: "memory");
        } else {
            XB_SPIN(xb_ld(&bar[XB_XGEN(b.x)]) == gen, bar);
            __builtin_amdgcn_fence(__ATOMIC_ACQUIRE, "agent");
            asm volatile("s_waitcnt vmcnt(0)" ::: "memory");
        }
    }
    __syncthreads();
}

enum { I_XP = 0, I_XS, I_PP, I_PS, I_CK, I_CV, I_CLF, I_SRE, I_SIM, I_GIN, I_WIN, I_BF, I_ARE, I_AIM, I_LDT, I_BRE, I_BIM, I_CRE, I_CIM, I_DSK, I_WGLU, I_WOUT, I_WPE, I_GPE, I_WPG, I_GFIN, N_IN };
struct Args { const float* in[N_IN]; float* out; unsigned char* ws; int ph_lo, ph_hi; };
typedef const __attribute__((address_space(4))) Args* KArgs;
__device__ __forceinline__ KArgs launder_kernarg() { KArgs p = (KArgs)__builtin_amdgcn_kernarg_segment_ptr(); asm volatile("" : "+s"(p)); return p; }

using pg8::Unit; using pg8::BM; using pg8::HALF; using pg8::cvt_pk_bf16; using pg8::pack8f; using pg8::bf_lo; using pg8::bf_hi; using pg8::sigmoidf_; using pg8::siluf_; using pg8::gelu_tanh_;
#define EPI_ARGS const f32x4 (&acc)[2][2][4][2], const Unit& u, int wr, int wc, int fr, int fq
struct EpiInProj { static constexpr bool PERM = true, AFTER_DRAIN = false;
    bf16 *Q, *K, *V, *SGA, *SGS, *UH; float *kp, *vp, *ks, *vs; float *QSS, *KSS;
    __device__ __forceinline__ void operator()(EPI_ARGS) const {
        const int seg = u.pn >> 2, csb = (u.pn & 3) * 256 + wc * 32 + 8 * fq, row0 = u.pm * BM + wr * 64 + fr;
        if (seg == 0 || seg == 3 || seg == 5) {
            bf16* dst = seg == 0 ? Q : (seg == 3 ? SGA : SGS);
#pragma unroll
            for (int ai = 0; ai < 2; ++ai)
#pragma unroll
                for (int m = 0; m < 4; ++m) { bf16* rowp = dst + (size_t)(row0 + ai * HALF + m * 16) * 1024 + csb;
#pragma unroll
                    for (int bj = 0; bj < 2; ++bj) { f32x4 v0 = acc[ai][bj][m][0], v1 = acc[ai][bj][m][1];
                        if (seg != 0) { for (int i = 0; i < 4; ++i) { v0[i] = siluf_(v0[i]); v1[i] = siluf_(v1[i]); } }
                        else { float ss = (v0[0] * v0[0] + v0[1] * v0[1]) + (v0[2] * v0[2] + v0[3] * v0[3]) + (v1[0] * v1[0] + v1[1] * v1[1]) + (v1[2] * v1[2] + v1[3] * v1[3]);
                            ss += __shfl_xor(ss, 16); ss += __shfl_xor(ss, 32);
                            if (fq == 0) QSS[((size_t)(row0 + ai * HALF + m * 16) * 8 + (u.pn & 3) * 2 + bj) * 4 + wc] = ss; }
                        *(v4u*)(rowp + bj * HALF) = pack8f(v0, v1); } }
        } else if (seg == 1 || seg == 2) {
            bf16* dst = seg == 1 ? K : V; float* o32 = u.pm < MP / BM ? (seg == 1 ? kp : vp) : (seg == 1 ? ks : vs) - (size_t)MP * 1024;
#pragma unroll
            for (int ai = 0; ai < 2; ++ai)
#pragma unroll
                for (int m = 0; m < 4; ++m) { const size_t ro = (size_t)(row0 + ai * HALF + m * 16) * 1024 + csb;
#pragma unroll
                    for (int bj = 0; bj < 2; ++bj) { const f32x4 v0 = acc[ai][bj][m][0], v1 = acc[ai][bj][m][1];
                        if (seg == 1) { float ss = (v0[0] * v0[0] + v0[1] * v0[1]) + (v0[2] * v0[2] + v0[3] * v0[3]) + (v1[0] * v1[0] + v1[1] * v1[1]) + (v1[2] * v1[2] + v1[3] * v1[3]);
                            ss += __shfl_xor(ss, 16); ss += __shfl_xor(ss, 32);
                            if (fq == 0) KSS[((size_t)(row0 + ai * HALF + m * 16) * 8 + (u.pn & 3) * 2 + bj) * 4 + wc] = ss; }
                        *(v4u*)(dst + ro + bj * HALF) = pack8f(v0, v1); *(f32x4*)(o32 + ro + bj * HALF) = v0; *(f32x4*)(o32 + ro + bj * HALF + 4) = v1; } }
        } else {
#pragma unroll
            for (int ai = 0; ai < 2; ++ai)
#pragma unroll
                for (int m = 0; m < 4; ++m) { const int row = row0 + ai * HALF + m * 16, chunk = row >> 5, s = row & 31;
#pragma unroll
                    for (int bj = 0; bj < 2; ++bj) { const int cs = csb + bj * HALF, g = cs >> 4, c0 = cs & 15;
                        *(v4u*)(UH + ((size_t)g * UHROWS + chunk) * UHLD + s * 16 + c0) = pack8f(acc[ai][bj][m][0], acc[ai][bj][m][1]); } }
        }
    }
};
struct EpiPle { static constexpr bool PERM = true, AFTER_DRAIN = false;
    bf16* E; float* ESS;
    __device__ __forceinline__ void operator()(EPI_ARGS) const {
        const int col0 = u.pn * BM + wc * 32 + 8 * fq, row0 = u.pm * BM + wr * 64 + fr;
#pragma unroll
        for (int ai = 0; ai < 2; ++ai)
#pragma unroll
            for (int m = 0; m < 4; ++m) { const int row = row0 + ai * HALF + m * 16; float ss = 0.f;
#pragma unroll
                for (int bj = 0; bj < 2; ++bj) { const f32x4 v0 = acc[ai][bj][m][0], v1 = acc[ai][bj][m][1];
                    ss += (v0[0] * v0[0] + v0[1] * v0[1]) + (v0[2] * v0[2] + v0[3] * v0[3]) + (v1[0] * v1[0] + v1[1] * v1[1]) + (v1[2] * v1[2] + v1[3] * v1[3]);
                    *(v4u*)(E + (size_t)row * DM + col0 + bj * HALF) = pack8f(v0, v1); }
                ss += __shfl_xor(ss, 16); ss += __shfl_xor(ss, 32);
                if (fq == 0) ESS[(size_t)row * 32 + u.pn * 4 + wc] = ss; }
    }
};
struct EpiGlu { static constexpr bool PERM = true, AFTER_DRAIN = false;
    const bf16 *YACT, *SGS; bf16* MIXED;
    __device__ __forceinline__ void operator()(EPI_ARGS) const {
        const int col0 = u.pn * BM + wc * 32 + 8 * fq, row0 = u.pm * BM + wr * 64 + fr;
#pragma unroll
        for (int ai = 0; ai < 2; ++ai) { v4u ya[4][2], sg[4][2];
#pragma unroll
            for (int m = 0; m < 4; ++m)
#pragma unroll
                for (int bj = 0; bj < 2; ++bj) { const size_t o = (size_t)(row0 + ai * HALF + m * 16) * 1024 + col0 + bj * HALF; ya[m][bj] = *(const v4u*)(YACT + o); sg[m][bj] = *(const v4u*)(SGS + o); }
#pragma unroll
            for (int m = 0; m < 4; ++m) { const int row = row0 + ai * HALF + m * 16;
#pragma unroll
                for (int bj = 0; bj < 2; ++bj) { const v4u y = ya[m][bj], g = sg[m][bj]; f32x4 v0 = acc[ai][bj][m][0], v1 = acc[ai][bj][m][1];
                    v0[0] = bf_lo(y.x) * sigmoidf_(v0[0]) * bf_lo(g.x); v0[1] = bf_hi(y.x) * sigmoidf_(v0[1]) * bf_hi(g.x);
                    v0[2] = bf_lo(y.y) * sigmoidf_(v0[2]) * bf_lo(g.y); v0[3] = bf_hi(y.y) * sigmoidf_(v0[3]) * bf_hi(g.y);
                    v1[0] = bf_lo(y.z) * sigmoidf_(v1[0]) * bf_lo(g.z); v1[1] = bf_hi(y.z) * sigmoidf_(v1[1]) * bf_hi(g.z);
                    v1[2] = bf_lo(y.w) * sigmoidf_(v1[2]) * bf_lo(g.w); v1[3] = bf_hi(y.w) * sigmoidf_(v1[3]) * bf_hi(g.w);
                    *(v4u*)(MIXED + (size_t)row * DM + 1024 + col0 + bj * HALF) = pack8f(v0, v1); } } }
    }
};
struct EpiOut { static constexpr bool PERM = true, AFTER_DRAIN = false;
    const float *xp, *xs; bf16* HB;
    __device__ __forceinline__ void operator()(EPI_ARGS) const {
        const int col0 = u.pn * BM + wc * 32 + 8 * fq, row0 = u.pm * BM + wr * 64 + fr;
        const float* xb = u.pm < MP / BM ? xp : xs - (size_t)MP * DM;
#pragma unroll
        for (int ai = 0; ai < 2; ++ai) { f32x4 xr[4][2][2];
#pragma unroll
            for (int m = 0; m < 4; ++m)
#pragma unroll
                for (int bj = 0; bj < 2; ++bj) { const size_t o = (size_t)(row0 + ai * HALF + m * 16) * DM + col0 + bj * HALF; xr[m][bj][0] = *(const f32x4*)(xb + o); xr[m][bj][1] = *(const f32x4*)(xb + o + 4); }
#pragma unroll
            for (int m = 0; m < 4; ++m)
#pragma unroll
                for (int bj = 0; bj < 2; ++bj) { const size_t o = (size_t)(row0 + ai * HALF + m * 16) * DM + col0 + bj * HALF;
                    *(v4u*)(HB + o) = pack8f(acc[ai][bj][m][0] + xr[m][bj][0], acc[ai][bj][m][1] + xr[m][bj][1]); } }
    }
};
struct EpiPg { static constexpr bool PERM = true, AFTER_DRAIN = false;
    const bf16* HB; bf16* H2B; const bf16* E; const float *RSTDE, *gpe; float* H2SS;
    __device__ __forceinline__ void operator()(EPI_ARGS) const {
        const int col0 = u.pn * BM + wc * 32 + 8 * fq, row0 = u.pm * BM + wr * 64 + fr;
        f32x4 gp[2][2];
#pragma unroll
        for (int bj = 0; bj < 2; ++bj) { gp[bj][0] = *(const f32x4*)(gpe + col0 + bj * HALF); gp[bj][1] = *(const f32x4*)(gpe + col0 + bj * HALF + 4); }
#pragma unroll
        for (int ai = 0; ai < 2; ++ai) { v4u ee[4][2], hv[4][2]; float rsv[4];
#pragma unroll
            for (int m = 0; m < 4; ++m) { rsv[m] = RSTDE[row0 + ai * HALF + m * 16];
#pragma unroll
                for (int bj = 0; bj < 2; ++bj) { const size_t o = (size_t)(row0 + ai * HALF + m * 16) * DM + col0 + bj * HALF; ee[m][bj] = *(const v4u*)(E + o); hv[m][bj] = *(const v4u*)(HB + o); } }
#pragma unroll
            for (int m = 0; m < 4; ++m) { const int row = row0 + ai * HALF + m * 16; const float rs = rsv[m]; float ss = 0.f;
#pragma unroll
                for (int bj = 0; bj < 2; ++bj) { const size_t o = (size_t)row * DM + col0 + bj * HALF;
                    const v4u e = ee[m][bj], hh = hv[m][bj]; const f32x4 a0 = acc[ai][bj][m][0], a1 = acc[ai][bj][m][1];
                    f32x4 v0, v1;
                    v0[0] = bf_lo(hh.x) + bf_lo(e.x) * rs * gp[bj][0][0] * sigmoidf_(a0[0]); v0[1] = bf_hi(hh.x) + bf_hi(e.x) * rs * gp[bj][0][1] * sigmoidf_(a0[1]);
                    v0[2] = bf_lo(hh.y) + bf_lo(e.y) * rs * gp[bj][0][2] * sigmoidf_(a0[2]); v0[3] = bf_hi(hh.y) + bf_hi(e.y) * rs * gp[bj][0][3] * sigmoidf_(a0[3]);
                    v1[0] = bf_lo(hh.z) + bf_lo(e.z) * rs * gp[bj][1][0] * sigmoidf_(a1[0]); v1[1] = bf_hi(hh.z) + bf_hi(e.z) * rs * gp[bj][1][1] * sigmoidf_(a1[1]);
                    v1[2] = bf_lo(hh.w) + bf_lo(e.w) * rs * gp[bj][1][2] * sigmoidf_(a1[2]); v1[3] = bf_hi(hh.w) + bf_hi(e.w) * rs * gp[bj][1][3] * sigmoidf_(a1[3]);
                    ss += (v0[0] * v0[0] + v0[1] * v0[1]) + (v0[2] * v0[2] + v0[3] * v0[3]) + (v1[0] * v1[0] + v1[1] * v1[1]) + (v1[2] * v1[2] + v1[3] * v1[3]);
                    *(v4u*)(H2B + o) = pack8f(v0, v1); }
                ss += __shfl_xor(ss, 16); ss += __shfl_xor(ss, 32);
                if (fq == 0) H2SS[(size_t)row * 32 + u.pn * 4 + wc] = ss; } }
    }
};
struct EpiSsmS { static constexpr bool PERM = false, AFTER_DRAIN = false;
    float* SBUF;
    __device__ __forceinline__ void operator()(EPI_ARGS) const {
        float* base = SBUF + (size_t)(u.g * 5 + u.pm) * 256 * 128; const int col0 = wc * 32 + 4 * fq, row0 = wr * 64 + fr;
#pragma unroll
        for (int ai = 0; ai < 2; ++ai)
#pragma unroll
            for (int m = 0; m < 4; ++m)
#pragma unroll
                for (int n = 0; n < 2; ++n) *(f32x4*)(base + (size_t)(row0 + ai * HALF + m * 16) * 128 + col0 + n * 16) = acc[ai][0][m][n];
    }
};
struct EpiSsmY { static constexpr bool PERM = true, AFTER_DRAIN = false;
    bf16* YACT;
    __device__ __forceinline__ void operator()(EPI_ARGS) const {
        const int n0 = u.pn * BM + wc * 32 + 8 * fq, row0 = wr * 64 + fr;
#pragma unroll
        for (int ai = 0; ai < 2; ++ai)
#pragma unroll
            for (int m = 0; m < 4; ++m) { const int r = row0 + ai * HALF + m * 16;
                if (u.pm < 4 || r < DECB) {
#pragma unroll
                    for (int bj = 0; bj < 2; ++bj) { const int n = n0 + bj * HALF, s = n >> 4, c0 = n & 15; const int tok = (u.pm < 4 ? u.pm * SEQ : MP) + r * CHUNK + s;
                        f32x4 v0 = acc[ai][bj][m][0], v1 = acc[ai][bj][m][1];
                        for (int i = 0; i < 4; ++i) { v0[i] = gelu_tanh_(v0[i]); v1[i] = gelu_tanh_(v1[i]); }
                        *(v4u*)(YACT + (size_t)tok * DSSM + u.g * 16 + c0) = pack8f(v0, v1); } } }
    }
};
struct SsmSched { const bf16* UH; const bf16* Bt; size_t bgrp, btile; int it0, it1, nit, upi;
    __device__ bool next(int i, Unit& u) const { if (i >= nit * upi) return false; const int li = i / upi, item = li == 0 ? it0 : it1; u.g = item / 5; u.pm = item % 5; u.pn = i % upi; return true; }
    __device__ __forceinline__ const char* a_ptr(const Unit& u) const { return (const char*)(UH + ((size_t)u.g * UHROWS + (size_t)u.pm * 256) * UHLD); }
    __device__ __forceinline__ const char* b_ptr(const Unit& u) const { return (const char*)Bt + (size_t)u.g * bgrp + (size_t)u.pn * btile; }
    __device__ __forceinline__ void a_ready(const Unit&) const {}
    __device__ __forceinline__ void done(const Unit&) const {}
};

__device__ __forceinline__ void p0_transpose_item(const float* W, int ldw, int src_col0, bf16* WT, int K, int dst_row0, int k0, LAS float* scr, int lane) {
    float tv[32];
#pragma unroll
    for (int i = 0; i < 32; ++i) tv[i] = W[(size_t)(k0 + 2 * i + (lane >> 5)) * ldw + src_col0 + (lane & 31)];
#pragma unroll
    for (int i = 0; i < 32; ++i) scr[(2 * i + (lane >> 5)) * 33 + (lane & 31)] = tv[i];
    LDS_WAIT(); asm volatile("" ::: "memory");
    const int c = lane & 7;
#pragma unroll
    for (int j = 0; j < 4; ++j) { const int n = (lane >> 3) + 8 * j; const LAS float* s = scr + (8 * c) * 33 + n;
        v4u o; o.x = pk2(s[0 * 33], s[1 * 33]); o.y = pk2(s[2 * 33], s[3 * 33]); o.z = pk2(s[4 * 33], s[5 * 33]); o.w = pk2(s[6 * 33], s[7 * 33]);
        *(GAS v4u*)(WT + (size_t)(dst_row0 + n) * K + k0 + 8 * c) = o; }
    LDS_WAIT(); asm volatile("" ::: "memory");
}
__device__ __forceinline__ void ssm_tables(KArgs a, LAS unsigned char* lds, int g, int q) {
    const int tid = threadIdx.x;
    LAS float* bbr = (LAS float*)lds;
    LAS float* bbi = bbr + 1024;
    LAS float* Cr = bbi + 1024;
    LAS float* Ci = Cr + 1024;
    LAS float* apr = Ci + 1024;
    LAS float* api = apr + 64 * 33;
    LAS float* Kc = api + 64 * 33;
    if (tid < 64) { const int p = tid;
        const double dt = exp((double)a->in[I_LDT][g]);
        const double ar = a->in[I_ARE][g * 64 + p], ai = a->in[I_AIM][g * 64 + p];
        const double mag = exp(ar * dt), ang = ai * dt; const double abr = mag * cos(ang), abi = mag * sin(ang);
        const double nr = abr - 1.0, ni = abi, den = ar * ar + ai * ai; const double cr = (nr * ar + ni * ai) / den, ci = (ni * ar - nr * ai) / den;
        for (int c = 0; c < 16; ++c) { const double br = a->in[I_BRE][(size_t)(g * 64 + p) * 16 + c], bi = a->in[I_BIM][(size_t)(g * 64 + p) * 16 + c];
            bbr[p * 16 + c] = (float)(cr * br - ci * bi); bbi[p * 16 + c] = (float)(cr * bi + ci * br); }
        double pr = 1.0, pi = 0.0;
        for (int t = 0; t <= 32; ++t) { apr[p * 33 + t] = (float)pr; api[p * 33 + t] = (float)pi; const double nr2 = pr * abr - pi * abi, ni2 = pr * abi + pi * abr; pr = nr2; pi = ni2; }
        if (q == 0) { float* A32 = (float*)(a->ws + WS_A32); A32[(g * 64 + p) * 2] = apr[p * 33 + 32]; A32[(g * 64 + p) * 2 + 1] = api[p * 33 + 32]; }
    }
    for (int e = tid; e < 1024; e += NTHR) { const int c = e >> 6, p = e & 63; Cr[p * 16 + c] = a->in[I_CRE][(size_t)g * 1024 + e]; Ci[p * 16 + c] = a->in[I_CIM][(size_t)g * 1024 + e]; }
    __syncthreads();
    { const int t = tid >> 4, c = tid & 15; float sum[16];
#pragma unroll
      for (int j = 0; j < 16; ++j) sum[j] = 0.f;
      for (int p = 0; p < 64; ++p) { const float cr = Cr[p * 16 + c], ci = Ci[p * 16 + c], pr = apr[p * 33 + t], pi = api[p * 33 + t];
          const float car = cr * pr - ci * pi, cai = cr * pi + ci * pr;
#pragma unroll
          for (int j4 = 0; j4 < 4; ++j4) { const f32x4 br = *(const LAS f32x4*)(bbr + p * 16 + 4 * j4), bi = *(const LAS f32x4*)(bbi + p * 16 + 4 * j4);
#pragma unroll
              for (int i = 0; i < 4; ++i) sum[4 * j4 + i] += car * br[i] - cai * bi[i]; } }
      if (t == 0) sum[c] += a->in[I_DSK][g * 16 + c];
#pragma unroll
      for (int j4 = 0; j4 < 4; ++j4) *(LAS f32x4*)(Kc + (t * 16 + c) * 16 + 4 * j4) = (f32x4){sum[4 * j4], sum[4 * j4 + 1], sum[4 * j4 + 2], sum[4 * j4 + 3]}; }
    __syncthreads();
    bf16* MW = (bf16*)(a->ws + WS_MW_T) + (size_t)g * 512 * UHLD;
    for (int idx = tid; idx < 128 * 80; idx += NTHR) { const int n = q * 128 + idx / 80, k0 = (idx % 80) * 8, s = n >> 4, c = n & 15; float v[8];
        if (k0 < 512) { const int s2 = k0 >> 4, c0 = k0 & 15;
#pragma unroll
            for (int j = 0; j < 8; ++j) v[j] = s2 <= s ? Kc[((s - s2) * 16 + c) * 16 + c0 + j] : 0.f;
        } else if (k0 < 576) {
#pragma unroll
            for (int j = 0; j < 8; ++j) { const int p = k0 - 512 + j; v[j] = Cr[p * 16 + c] * apr[p * 33 + s + 1] - Ci[p * 16 + c] * api[p * 33 + s + 1]; }
        } else {
#pragma unroll
            for (int j = 0; j < 8; ++j) { const int p = k0 - 576 + j; v[j] = -(Cr[p * 16 + c] * api[p * 33 + s + 1] + Ci[p * 16 + c] * apr[p * 33 + s + 1]); }
        }
        v4u o; o.x = pk2(v[0], v[1]); o.y = pk2(v[2], v[3]); o.z = pk2(v[4], v[5]); o.w = pk2(v[6], v[7]);
        *(GAS v4u*)(MW + (size_t)n * UHLD + k0) = o; }
    bf16* BP = (bf16*)(a->ws + WS_BP_T) + (size_t)g * 256 * 512;
    for (int idx = tid; idx < 64 * 64; idx += NTHR) { const int n = q * 64 + (idx >> 6), k0 = (idx & 63) * 8, s2 = k0 >> 4, c0 = k0 & 15; float v[8];
#pragma unroll
        for (int j = 0; j < 8; ++j) {
            if (n < 64) v[j] = apr[n * 33 + 31 - s2] * bbr[n * 16 + c0 + j] - api[n * 33 + 31 - s2] * bbi[n * 16 + c0 + j];
            else if (n < 128) { const int p = n - 64; v[j] = apr[p * 33 + 31 - s2] * bbi[p * 16 + c0 + j] + api[p * 33 + 31 - s2] * bbr[p * 16 + c0 + j]; }
            else v[j] = 0.f; }
        v4u o; o.x = pk2(v[0], v[1]); o.y = pk2(v[2], v[3]); o.z = pk2(v[4], v[5]); o.w = pk2(v[6], v[7]);
        *(GAS v4u*)(BP + (size_t)n * 512 + k0) = o; }
    __syncthreads();
}
__device__ __forceinline__ float log_sigmoid_(float z) { return z >= 0.f ? -log1pf(expf(-z)) : z - log1pf(expf(z)); }
__device__ __forceinline__ void phase0(KArgs a, LAS unsigned char* lds) {
    const int tid = threadIdx.x, lane = tid & 63, wave = __builtin_amdgcn_readfirstlane(tid >> 6);
    const int gw = blockIdx.x * NWAVES + wave, NGW = gridDim.x * NWAVES;
    for (int it = blockIdx.x; it < NG * 4; it += gridDim.x) ssm_tables(a, lds, it >> 2, it & 3);
    { LAS float* scr = (LAS float*)(lds + wave * 16384);
      const int tw = gw, TNW = NGW;
      constexpr int I_IN = 32 * 192, I_GLU = 16 * 32, I_OUT = 32 * 64, I_PE = 4 * 64, I_PG = 32 * 64, NITEMS = I_IN + I_GLU + I_OUT + I_PE + I_PG;
      for (int it = tw; it < NITEMS; it += TNW) { int r = it;
          if (r < I_IN) { const int kb = r / 192, nb = r % 192; p0_transpose_item(a->in[I_WIN], DIN, 32 * nb + (nb >= 96 ? 8 : 0), (bf16*)(a->ws + WS_WIN_T), DM, 32 * nb, 64 * kb, scr, lane); continue; } r -= I_IN;
          if (r < I_GLU) { const int kb = r / 32, nb = r % 32; p0_transpose_item(a->in[I_WGLU], DSSM, 32 * nb, (bf16*)(a->ws + WS_WGLU_T), DSSM, 32 * nb, 64 * kb, scr, lane); continue; } r -= I_GLU;
          if (r < I_OUT) { const int kb = r / 64, nb = r % 64; p0_transpose_item(a->in[I_WOUT], DM, 32 * nb, (bf16*)(a->ws + WS_WOUT_T), DM, 32 * nb, 64 * kb, scr, lane); continue; } r -= I_OUT;
          if (r < I_PE) { const int kb = r / 64, nb = r % 64; p0_transpose_item(a->in[I_WPE], DM, 32 * nb, (bf16*)(a->ws + WS_WPE_T), DPLE, 32 * nb, 64 * kb, scr, lane); continue; } r -= I_PE;
          { const int kb = r / 64, nb = r % 64; p0_transpose_item(a->in[I_WPG], DM, 32 * nb, (bf16*)(a->ws + WS_WPG_T), DM, 32 * nb, 64 * kb, scr, lane); } } }
    __syncthreads();
    LAS float* wfT = (LAS float*)lds;
    { float tw[32];
#pragma unroll
      for (int i = 0; i < 32; ++i) { const int e = tid + NTHR * i; tw[i] = a->in[I_WIN][(size_t)(e >> 3) * DIN + OFF_F + (e & 7)]; }
#pragma unroll
      for (int i = 0; i < 32; ++i) { const int e = tid + NTHR * i; wfT[(e & 7) * DM + (e >> 3)] = tw[i]; } }
    __syncthreads();
    f32x4 gi[8];
#pragma unroll
    for (int j = 0; j < 8; ++j) gi[j] = *(const f32x4*)(a->in[I_GIN] + 256 * j + 4 * lane);
    float* LOGF = (float*)(a->ws + WS_LOGF);
    const int hsel = (lane & 1) * 4 + ((lane >> 1) & 1) * 2 + ((lane >> 2) & 1);
    const float bfs = a->in[I_BF][hsel];
    f32x4 vn[8], vm[8]; f32x4 pn4, pm4;
#define P0_LOAD(dst, pdst, r_) do { const bool pr_ = (r_) < MP; const float* xr_ = pr_ ? a->in[I_XP] + (size_t)(r_) * DM : a->in[I_XS] + (size_t)((r_) - MP) * DM; \
        _Pragma("unroll") for (int j = 0; j < 8; ++j) dst[j] = *(const f32x4*)(xr_ + 256 * j + 4 * lane); \
        pdst = *(const f32x4*)((pr_ ? a->in[I_PP] + (size_t)(r_) * DPLE : a->in[I_PS] + (size_t)((r_) - MP) * DPLE) + 4 * lane); } while (0)
    if (gw < MT) P0_LOAD(vn, pn4, gw);
    if (gw + NGW < MT) P0_LOAD(vm, pm4, gw + NGW);
    for (int row = gw; row < MT; row += NGW) {
        const bool pr = row < MP;
        f32x4 v[8]; const f32x4 pv = pn4;
#pragma unroll
        for (int j = 0; j < 8; ++j) { v[j] = vn[j]; vn[j] = vm[j]; }
        pn4 = pm4;
        if (row + 2 * NGW < MT) P0_LOAD(vm, pm4, row + 2 * NGW);
        float ss = 0.f;
#pragma unroll
        for (int j = 0; j < 8; ++j) { ss += (v[j][0] * v[j][0] + v[j][1] * v[j][1]) + (v[j][2] * v[j][2] + v[j][3] * v[j][3]); v[j] = v[j] * gi[j]; }
        float d[8];
#pragma unroll
        for (int h = 0; h < 8; ++h) { float s = 0.f;
#pragma unroll
            for (int j = 0; j < 8; ++j) { const f32x4 w = *(const LAS f32x4*)(wfT + h * DM + 256 * j + 4 * lane); s += (v[j][0] * w[0] + v[j][1] * w[1]) + (v[j][2] * w[2] + v[j][3] * w[3]); }
            d[h] = s; __builtin_amdgcn_sched_barrier(0); }
        float a4[4], c2[2], fl;
        { const bool b0 = lane & 1, b1 = lane & 2, b2 = lane & 4;
#pragma unroll
          for (int i = 0; i < 4; ++i) { const float snd = b0 ? d[i] : d[i + 4], kp = b0 ? d[i + 4] : d[i]; a4[i] = kp + __shfl_xor(snd, 1); }
#pragma unroll
          for (int i = 0; i < 2; ++i) { const float snd = b1 ? a4[i] : a4[i + 2], kp = b1 ? a4[i + 2] : a4[i]; c2[i] = kp + __shfl_xor(snd, 2); }
          { const float snd = b2 ? c2[0] : c2[1], kp = b2 ? c2[1] : c2[0]; fl = kp + __shfl_xor(snd, 4); }
          fl += __shfl_xor(fl, 8); fl += __shfl_xor(fl, 16); fl += __shfl_xor(fl, 32); }
        const float rstd = 1.0f / sqrtf(wave_sum(ss) * (1.0f / DM) + EPS);
        bf16* xo = (bf16*)(a->ws + WS_XN) + (size_t)row * DM;
#pragma unroll
        for (int j = 0; j < 8; ++j) { const f32x4 n = v[j] * rstd; v2u w; w.x = pk2(n[0], n[1]); w.y = pk2(n[2], n[3]); *(GAS v2u*)(xo + 256 * j + 4 * lane) = w; }
        if (lane < 8) { const float lf = log_sigmoid_(fl * rstd + bfs); LOGF[(size_t)row * 8 + hsel] = lf;
            (pr ? a->out + O_LFP + (size_t)row * 8 : a->out + O_LFS + (size_t)(row - MP) * 8)[hsel] = lf; }
        v2u w; w.x = pk2(pv[0], pv[1]); w.y = pk2(pv[2], pv[3]);
        *(GAS v2u*)((bf16*)(a->ws + WS_PB) + (size_t)row * DPLE + 4 * lane) = w;
    }
#undef P0_LOAD
}
__device__ __forceinline__ void forget_cumsum(KArgs a, LAS unsigned char* lds) {
    const int bid = blockIdx.x, tid = threadIdx.x;
    if (bid < NB + DECB) {
        LAS double* sseg = (LAS double*)lds;
        const int h = tid & 7, seg = tid >> 3; const float* LOGF = (const float*)(a->ws + WS_LOGF);
        const bool pr = bid < NB; const int b = pr ? bid : bid - NB, n = pr ? SEQ : PAST + DECS, L = pr ? 128 : 65;
        const float* s0 = pr ? LOGF + (size_t)b * SEQ * 8 + h : a->in[I_CLF] + (size_t)b * PAST * 8 + h;
        const float* s1 = LOGF + ((size_t)MP + (size_t)b * DECS) * 8 + h;
        const int n0 = pr ? SEQ : PAST;
        float* out = pr ? (float*)(a->ws + WS_CP) + (size_t)(b * NH + h) * SEQ : (float*)(a->ws + WS_CS) + (size_t)(b * NH + h) * CSLD;
        const int t0 = seg * L, t1 = (t0 + L < n) ? t0 + L : n;
        double s = 0.0;
        for (int t = t0; t < t1; ++t) s += (double)(t < n0 ? s0[(size_t)t * 8] : s1[(size_t)(t - n0) * 8]);
        sseg[seg * 8 + h] = s; __syncthreads();
        double pre = 0.0; for (int j = 0; j < seg; ++j) pre += sseg[j * 8 + h];
        for (int t = t0; t < t1; ++t) { pre += (double)(t < n0 ? s0[(size_t)t * 8] : s1[(size_t)(t - n0) * 8]); out[t] = (float)(pre * 11.313708498984761); }
        if (!pr && seg == 63) { const float last = (float)(pre * 11.313708498984761); for (int t = n; t < CSLD; ++t) out[t] = last; }
        __syncthreads();
    }
}
__device__ __forceinline__ void ssm_scan(KArgs a, int item, int lane) {
    const int g = item / 5, u = item % 5, p = lane;
    const float* S = (const float*)(a->ws + WS_SBUF) + (size_t)item * 256 * 128;
    bf16* UH = (bf16*)(a->ws + WS_UH) + ((size_t)g * UHROWS + (size_t)u * 256) * UHLD;
    const float a32r = ((const float*)(a->ws + WS_A32))[(g * 64 + p) * 2], a32i = ((const float*)(a->ws + WS_A32))[(g * 64 + p) * 2 + 1];
    if (u < 4) {
        float hr = 0.f, hi = 0.f;
        for (int j = 0; j < 256; ++j) {
            UH[(size_t)j * UHLD + 512 + p] = (bf16)f2bf(hr); UH[(size_t)j * UHLD + 576 + p] = (bf16)f2bf(hi);
            const float sr = S[j * 128 + p], si = S[j * 128 + 64 + p];
            const float nr = a32r * hr - a32i * hi + sr, ni = a32r * hi + a32i * hr + si; hr = nr; hi = ni; }
        a->out[O_SRP + (size_t)(u * NG + g) * NST + p] = hr; a->out[O_SIP + (size_t)(u * NG + g) * NST + p] = hi;
    } else {
        for (int j = 0; j < DECB; ++j) {
            const float hr = a->in[I_SRE][(size_t)(j * NG + g) * NST + p], hi = a->in[I_SIM][(size_t)(j * NG + g) * NST + p];
            UH[(size_t)j * UHLD + 512 + p] = (bf16)f2bf(hr); UH[(size_t)j * UHLD + 576 + p] = (bf16)f2bf(hi);
            const float sr = S[j * 128 + p], si = S[j * 128 + 64 + p];
            a->out[O_SRS + (size_t)(j * NG + g) * NST + p] = a32r * hr - a32i * hi + sr; a->out[O_SIS + (size_t)(j * NG + g) * NST + p] = a32r * hi + a32i * hr + si; }
    }
}
__device__ __forceinline__ float dpp_rowsum16(float v) {
    v += __int_as_float(__builtin_amdgcn_update_dpp(0, __float_as_int(v), 0xB1, 0xF, 0xF, true));
    v += __int_as_float(__builtin_amdgcn_update_dpp(0, __float_as_int(v), 0x4E, 0xF, 0xF, true));
    v += __int_as_float(__builtin_amdgcn_update_dpp(0, __float_as_int(v), 0x141, 0xF, 0xF, true));
    v += __int_as_float(__builtin_amdgcn_update_dpp(0, __float_as_int(v), 0x140, 0xF, 0xF, true));
    return v;
}
__device__ __forceinline__ void cache_knorm_pass(KArgs a, int widx, int nw, int lane) {
    const float* CK = a->in[I_CK]; unsigned* kcm = (unsigned*)(a->ws + WS_CTL) + CW_KCM;
    constexpr int IPB = PAST / 16;
    for (int it = widx; it < DECB * IPB; it += nw) {
        const int b = it / IPB, s0 = (it % IPB) * 16; float mx[4] = {0.f, 0.f, 0.f, 0.f};
#pragma unroll 1
        for (int g = 0; g < 4; ++g) { f32x4 v[4][4];
#pragma unroll
            for (int kk = 0; kk < 4; ++kk)
#pragma unroll
                for (int j = 0; j < 4; ++j) v[kk][j] = *(const f32x4*)(CK + (size_t)(b * PAST + s0 + 4 * g + kk) * 1024 + 4 * (lane + 64 * j));
#pragma unroll
            for (int kk = 0; kk < 4; ++kk)
#pragma unroll
                for (int j = 0; j < 4; ++j) { float ss = (v[kk][j][0] * v[kk][j][0] + v[kk][j][1] * v[kk][j][1]) + (v[kk][j][2] * v[kk][j][2] + v[kk][j][3] * v[kk][j][3]);
                    ss = dpp_rowsum16(ss); ss += __shfl_xor(ss, 16); mx[j] = fmaxf(mx[j], ss); } }
        if ((lane & 31) == 0) {
#pragma unroll
            for (int j = 0; j < 4; ++j) atomicMax(kcm + b * 8 + 2 * j + (lane >> 5), __float_as_uint(mx[j])); }
    }
}
constexpr float PRUNE_T = 36.0f;
__device__ __forceinline__ float dpp_max_step(float v, const int ctrl_sel) {
    int x = __float_as_int(v), y;
    if (ctrl_sel == 0) y = __builtin_amdgcn_update_dpp(x, x, 0xB1, 0xF, 0xF, false);
    else if (ctrl_sel == 1) y = __builtin_amdgcn_update_dpp(x, x, 0x4E, 0xF, 0xF, false);
    else if (ctrl_sel == 2) y = __builtin_amdgcn_update_dpp(x, x, 0x141, 0xF, 0xF, false);
    else y = __builtin_amdgcn_update_dpp(x, x, 0x140, 0xF, 0xF, false);
    return fmaxf(v, __int_as_float(y));
}
__device__ __forceinline__ float block_max(float v, LAS float* red, int lane, int wave) {
    v = dpp_max_step(v, 0); v = dpp_max_step(v, 1); v = dpp_max_step(v, 2); v = dpp_max_step(v, 3);
    const float w = fmaxf(fmaxf(__int_as_float(__builtin_amdgcn_readlane(__float_as_int(v), 0)), __int_as_float(__builtin_amdgcn_readlane(__float_as_int(v), 16))),
                          fmaxf(__int_as_float(__builtin_amdgcn_readlane(__float_as_int(v), 32)), __int_as_float(__builtin_amdgcn_readlane(__float_as_int(v), 48))));
    __syncthreads(); if (lane == 0) red[wave] = w; __syncthreads();
    float m = red[0];
#pragma unroll
    for (int k = 1; k < NWAVES; ++k) m = fmaxf(m, red[k]);
    return __uint_as_float(__builtin_amdgcn_readfirstlane(__float_as_uint(m)));
}
__device__ __forceinline__ float fox_kmax2(KArgs a, int bh, LAS float* red) {
    int tid = threadIdx.x; asm volatile("" : "+v"(tid));
    const int b = bh >> 3, h = bh & 7; const float* KSS = (const float*)(a->ws + WS_KSS); float m = 0.f;
    f32x4 v[SEQ / NTHR];
#pragma unroll
    for (int i = 0; i < SEQ / NTHR; ++i) v[i] = *(const f32x4*)(KSS + ((size_t)(b * SEQ + tid + NTHR * i) * 8 + h) * 4);
#pragma unroll
    for (int i = 0; i < SEQ / NTHR; ++i) m = fmaxf(m, (v[i][0] + v[i][1]) + (v[i][2] + v[i][3]));
    return block_max(m, red, tid & 63, tid >> 6);
}
__device__ __forceinline__ int fox_jlo(KArgs a, int bh, int qb, float kmax2, LAS float* red) {
    int tid = threadIdx.x; asm volatile("" : "+v"(tid));
    const int b = bh >> 3, h = bh & 7, P0 = qb * 256; const float* QSS = (const float*)(a->ws + WS_QSS); float q2 = 0.f;
    if (tid < 256) { const f32x4 v = *(const f32x4*)(QSS + ((size_t)(b * SEQ + P0 + tid) * 8 + h) * 4); q2 = (v[0] + v[1]) + (v[2] + v[3]); }
    const float qmax2 = block_max(q2, red, tid & 63, tid >> 6);
    const float B = sqrtf(qmax2 * kmax2) * att::SCALE * 1.02f;
    const float thr = (PRUNE_T + 2.0f * B) * 11.313708498984761f;
    const float* cp = (const float*)(a->ws + WS_CP) + (size_t)(b * NH + h) * SEQ;
    const bool skip = tid < 4 * qb && cp[64 * tid + 63] - cp[P0] > thr;
    const float cnt = (float)__popcll(__ballot(skip));
    __syncthreads(); if ((tid & 63) == 0) red[8 + (tid >> 6)] = cnt; __syncthreads();
    return __builtin_amdgcn_readfirstlane((int)(red[8] + red[9]));
}
__device__ __forceinline__ att::BlockRef<att::bf16> prompt_ref(KArgs a, int bh, int qb, int jlo) {
    const int b = bh >> 3, h = bh & 7; att::BlockRef<att::bf16> r;
    const size_t row0 = (size_t)b * SEQ + (size_t)qb * 256, key0 = (size_t)b * SEQ + (size_t)jlo * 64;
    r.Q = (const bf16*)(a->ws + WS_Q) + row0 * 1024 + h * HD; r.K = (const bf16*)(a->ws + WS_K) + key0 * 1024 + h * HD; r.V = (const bf16*)(a->ws + WS_V) + key0 * 1024 + h * HD;
    r.Kn = r.K; r.Vn = r.V; r.O = (bf16*)(a->ws + WS_MIXED) + row0 * DM + h * HD; r.G = (const bf16*)(a->ws + WS_SGA) + row0 * 1024 + h * HD;
    const float* cp = (const float*)(a->ws + WS_CP) + (size_t)(b * NH + h) * SEQ;
    r.CK = cp + jlo * 64; r.CQ = cp + qb * 256; r.np = 0x7fffffff; r.P0 = qb * 256 - jlo * 64; r.jhi = 4 * qb + 4 - jlo;
    return r;
}
__device__ __forceinline__ int sample_jlo(KArgs a, int bh, LAS float* red) {
    int tid = threadIdx.x; asm volatile("" : "+v"(tid));
    const int b = bh >> 3, h = bh & 7; float q2 = 0.f, k2 = 0.f;
    if (tid < DECS) { const size_t o = ((size_t)(MP + b * DECS + tid) * 8 + h) * 4; const f32x4 vq = *(const f32x4*)((const float*)(a->ws + WS_QSS) + o), vk = *(const f32x4*)((const float*)(a->ws + WS_KSS) + o);
        q2 = (vq[0] + vq[1]) + (vq[2] + vq[3]); k2 = (vk[0] + vk[1]) + (vk[2] + vk[3]); }
    const float qmax2 = block_max(q2, red, tid & 63, tid >> 6);
    const float kmax2 = fmaxf(block_max(k2, red, tid & 63, tid >> 6), __uint_as_float(((const unsigned*)(a->ws + WS_CTL))[CW_KCM + b * 8 + h]));
    const float B = sqrtf(qmax2 * kmax2) * att::SCALE * 1.02f, thr = (PRUNE_T + 2.0f * B) * 11.313708498984761f;
    const float* cs = (const float*)(a->ws + WS_CS) + (size_t)(b * NH + h) * CSLD;
    const bool skip = tid < PAST / 64 && cs[64 * tid + 63] - cs[PAST] > thr;
    const float cnt = (float)__popcll(__ballot(skip));
    __syncthreads(); if ((tid & 63) == 0) red[8 + (tid >> 6)] = cnt; __syncthreads();
    return __builtin_amdgcn_readfirstlane((int)red[8]);
}
__device__ __forceinline__ att::BlockRef<float> sample_ref(KArgs a, int bh, int jlo) {
    const int b = bh >> 3, h = bh & 7; att::BlockRef<float> r;
    const size_t row0 = (size_t)MP + (size_t)b * DECS, key0 = (size_t)b * PAST + (size_t)jlo * 64;
    r.Q = (const bf16*)(a->ws + WS_Q) + row0 * 1024 + h * HD; r.K = a->in[I_CK] + key0 * 1024 + h * HD; r.V = a->in[I_CV] + key0 * 1024 + h * HD;
    r.Kn = a->out + O_KS + (size_t)b * DECS * 1024 + h * HD; r.Vn = a->out + O_VS + (size_t)b * DECS * 1024 + h * HD;
    r.O = (bf16*)(a->ws + WS_MIXED) + row0 * DM + h * HD; r.G = (const bf16*)(a->ws + WS_SGA) + row0 * 1024 + h * HD;
    const float* cs = (const float*)(a->ws + WS_CS) + (size_t)(b * NH + h) * CSLD;
    r.CK = cs + jlo * 64; r.CQ = cs + PAST; r.np = PAST - jlo * 64; r.P0 = PAST - jlo * 64; r.jhi = (PAST + 64) / 64 - jlo;
    return r;
}

__global__ void __launch_bounds__(NTHR, 2) fox_s5_fwd(Args args) {
    extern __shared__ __attribute__((aligned(16))) unsigned char lds_raw[];
    LAS unsigned char* lds = (LAS unsigned char*)lds_raw;
    const int G = gridDim.x, bid = blockIdx.x;
#define THREAD_IDS() int tid = threadIdx.x; asm volatile("" : "+v"(tid)); const int lane = tid & 63, wave = __builtin_amdgcn_readfirstlane(tid >> 6); (void)lane; (void)wave
    { THREAD_IDS(); for (int u = tid; u < (LDS_BYTES - LDSCTL_OFF) / 4; u += NTHR) ((LAS unsigned*)(lds + LDSCTL_OFF))[u] = 0u; }
    __syncthreads();
#if MK_ONE_LAUNCH
    XcdBarrier bar = xcd_barrier_post((unsigned*)(args.ws + WS_CTL) + CW_BAR, (volatile LAS unsigned*)(lds + MISC_OFF) + 8);
#define GRID_BAR() xcd_barrier(bar)
#else
#define GRID_BAR() do {} while (0)
#endif
    const int lo = args.ph_lo, hi = args.ph_hi;
#ifdef ONLY_PH
#define IN(k) ((k) == ONLY_PH && lo <= (k) && (k) < hi)
#else
#define IN(k) (lo <= (k) && (k) < hi)
#endif
#define BOTH(k) (IN(k) && IN((k) + 1))

    if (IN(0)) { KArgs A = launder_kernarg(); unsigned char* ws = A->ws; (void)ws; phase0(A, lds); if (BOTH(0)) GRID_BAR(); }

    if (IN(1)) { KArgs A = launder_kernarg(); unsigned char* ws = A->ws; (void)ws;
        forget_cumsum(A, lds);
        { pg8::Gemm g{DM, DM, DM}; pg8::StaticOrder S; S.init((const bf16*)(ws + WS_XN), (const bf16*)(ws + WS_WIN_T), DM, DM, MT, NIN, G, bid);
          EpiInProj E{(bf16*)(ws + WS_Q), (bf16*)(ws + WS_K), (bf16*)(ws + WS_V), (bf16*)(ws + WS_SGA), (bf16*)(ws + WS_SGS), (bf16*)(ws + WS_UH),
                      A->out + O_KP, A->out + O_VP, A->out + O_KS, A->out + O_VS, (float*)(ws + WS_QSS), (float*)(ws + WS_KSS)};
          pg8::gemm_phase<EpiInProj, pg8::StaticOrder, true, true>(lds + RING_OFF, g, S, E); }
        { const int nx = ((MT / 256) * (NIN / 256)) % G;
          THREAD_IDS();
          if (nx == 0 || G - nx < 8) cache_knorm_pass(A, bid * NWAVES + wave, G * NWAVES, lane);
          else if (bid >= nx) cache_knorm_pass(A, (bid - nx) * NWAVES + wave, (G - nx) * NWAVES, lane); }
        { pg8::Gemm g{DPLE, DPLE, DPLE}; pg8::StaticOrder S; S.init((const bf16*)(ws + WS_PB), (const bf16*)(ws + WS_WPE_T), DPLE, DPLE, MT, DM, G, bid);
          EpiPle E{(bf16*)(ws + WS_E), (float*)(ws + WS_ESS)};
          pg8::gemm_phase<EpiPle, pg8::StaticOrder, true, true>(lds + RING_OFF, g, S, E); }
        if (BOTH(1)) GRID_BAR();
    }

    if (IN(2)) { KArgs A = launder_kernarg(); unsigned char* ws = A->ws; (void)ws; THREAD_IDS();
        const bool sample_first = ((bid >> 3) & 1) != 0;
#define SAMPLE_ATT() do { att::Seam S_; for (int L_ = bid; L_ < DECB * NH; L_ += G) { const att::BlockRef<float> cur_ = sample_ref(A, L_, sample_jlo(A, L_, (LAS float*)(lds + RING_OFF + 65536))); \
            att::fox_prime<float, true>(cur_, (char*)lds_raw + RING_OFF, S_); att::fox_block<float, true>(cur_, cur_, (char*)lds_raw + RING_OFF, S_); VM_WAIT(); __syncthreads(); } } while (0)
        if (sample_first) { SAMPLE_ATT(); }
#if defined(PROBE_SUB) && PROBE_SUB == 3
        if (sample_first) { SAMPLE_ATT(); }
#endif
#ifndef NO_SSM
#if defined(PROBE_SUB) && PROBE_SUB == 1
        for (int rep_ = 0; rep_ < 2; ++rep_)
#endif
        { const int it0 = bid, it1 = bid + G, nit = it0 < NSSM_ITEMS ? (it1 < NSSM_ITEMS ? 2 : 1) : 0;
          if (nit > 0) {
            { pg8::Gemm g{UHLD, 512, 512}; SsmSched S{(const bf16*)(ws + WS_UH), (const bf16*)(ws + WS_BP_T), (size_t)256 * 512 * 2, 0, it0, it1, nit, 1};
              EpiSsmS E{(float*)(ws + WS_SBUF)};
              pg8::gemm_phase<EpiSsmS, SsmSched, false, true>(lds + RING_OFF, g, S, E); }
            VM_WAIT(); __syncthreads();
            if (wave < nit) ssm_scan(A, wave == 0 ? it0 : it1, lane);
            VM_WAIT(); __syncthreads();
            { pg8::Gemm g{UHLD, UHLD, UHLD}; SsmSched S{(const bf16*)(ws + WS_UH), (const bf16*)(ws + WS_MW_T), (size_t)512 * UHLD * 2, (size_t)256 * UHLD * 2, it0, it1, nit, 2};
              EpiSsmY E{(bf16*)(ws + WS_YACT)};
              pg8::gemm_phase<EpiSsmY, SsmSched, false, true>(lds + RING_OFF, g, S, E); }
          } }
#endif
        __syncthreads();
#ifndef NO_PATT
#if defined(PROBE_SUB) && PROBE_SUB == 2
        for (int rep_ = 0; rep_ < 2; ++rep_)
#endif
        { att::Seam S; int L = bid; LAS float* red = (LAS float*)(lds + RING_OFF + 65536);
          if (L < 512) {
            int pass = 0; float km2 = fox_kmax2(A, L >> 4, red);
            att::BlockRef<att::bf16> cur = prompt_ref(A, L >> 4, L & 15, fox_jlo(A, L >> 4, L & 15, km2, red));
            att::fox_prime<att::bf16, false>(cur, (char*)lds_raw + RING_OFF, S);
            for (;;) {
                int Ln = L, passn = pass + 1; if (pass == 1) { passn = 0; Ln = L + G; }
                const bool last = Ln >= 512;
                const int qbn = passn == 0 ? (Ln & 15) : 31 - (Ln & 15); int jn = 0;
                if (!last) { if (passn == 0) km2 = fox_kmax2(A, Ln >> 4, red); jn = fox_jlo(A, Ln >> 4, qbn, km2, red); }
                const att::BlockRef<att::bf16> nxt = last ? cur : prompt_ref(A, Ln >> 4, qbn, jn);
                att::fox_block<att::bf16, false>(cur, nxt, (char*)lds_raw + RING_OFF, S);
                if (last) break;
                cur = nxt; L = Ln; pass = passn;
            } } }
#endif
        __syncthreads();
        if (!sample_first) { SAMPLE_ATT(); }
#if defined(PROBE_SUB) && PROBE_SUB == 3
        if (!sample_first) { SAMPLE_ATT(); }
#endif
#undef SAMPLE_ATT
        if (BOTH(2)) GRID_BAR();
    }

    if (IN(3)) { KArgs A = launder_kernarg(); unsigned char* ws = A->ws; (void)ws; THREAD_IDS();
        { const int rpb = (MT + G - 1) / G; const int row = bid * rpb + tid;
          if (tid < rpb && row < MT) { const f32x4* p = (const f32x4*)((const float*)(ws + WS_ESS) + (size_t)row * 32); float ss = 0.f;
#pragma unroll
              for (int j = 0; j < 8; ++j) { const f32x4 v = p[j]; ss += (v[0] + v[1]) + (v[2] + v[3]); }
              ((float*)(ws + WS_RSTDE))[row] = 1.0f / sqrtf(ss * (1.0f / DM) + EPS); } }
        { pg8::Gemm g{DSSM, DSSM, DSSM}; pg8::StaticOrder S; S.init((const bf16*)(ws + WS_YACT), (const bf16*)(ws + WS_WGLU_T), DSSM, DSSM, MT, DSSM, G, bid);
          EpiGlu E{(const bf16*)(ws + WS_YACT), (const bf16*)(ws + WS_SGS), (bf16*)(ws + WS_MIXED)};
          pg8::gemm_phase<EpiGlu, pg8::StaticOrder, true, true>(lds + RING_OFF, g, S, E); }
        if (BOTH(3)) GRID_BAR();
    }

    if (IN(4)) { KArgs A = launder_kernarg(); unsigned char* ws = A->ws; (void)ws;
        { pg8::Gemm g{DM, DM, DM}; pg8::StaticOrder S; S.init((const bf16*)(ws + WS_MIXED), (const bf16*)(ws + WS_WOUT_T), DM, DM, MT, DM, G, bid);
          EpiOut E{A->in[I_XP], A->in[I_XS], (bf16*)(ws + WS_HB)};
          pg8::gemm_phase<EpiOut, pg8::StaticOrder, true, true>(lds + RING_OFF, g, S, E); }
        if (BOTH(4)) GRID_BAR();
    }

    if (IN(5)) { KArgs A = launder_kernarg(); unsigned char* ws = A->ws; (void)ws;
        { pg8::Gemm g{DM, DM, DM}; pg8::StaticOrder S; S.init((const bf16*)(ws + WS_HB), (const bf16*)(ws + WS_WPG_T), DM, DM, MT, DM, G, bid);
          EpiPg E{(const bf16*)(ws + WS_HB), (bf16*)(ws + WS_MIXED)  , (const bf16*)(ws + WS_E), (const float*)(ws + WS_RSTDE), A->in[I_GPE], (float*)(ws + WS_H2SS)};
          pg8::gemm_phase<EpiPg, pg8::StaticOrder, true, true>(lds + RING_OFF, g, S, E); }
        if (BOTH(5)) GRID_BAR();
    }

    if (IN(6)) { KArgs A = launder_kernarg(); unsigned char* ws = A->ws; (void)ws; THREAD_IDS();
        const int gw = bid * NWAVES + wave, NGW = G * NWAVES;
        f32x4 gf[8];
#pragma unroll
        for (int j = 0; j < 8; ++j) gf[j] = *(const f32x4*)(A->in[I_GFIN] + 512 * (j >> 1) + 8 * lane + 4 * (j & 1));
        for (int row = gw; row < MT; row += NGW) {
            float ss = lane < 32 ? ((const float*)(ws + WS_H2SS))[(size_t)row * 32 + lane] : 0.f;
            const float rstd = 1.0f / sqrtf(wave_sum(ss) * (1.0f / DM) + EPS);
            float* yr = row < MP ? A->out + O_YP + (size_t)row * DM : A->out + O_YS + (size_t)(row - MP) * DM;
            const bf16* hr = (const bf16*)(ws + WS_MIXED) + (size_t)row * DM;
#pragma unroll
            for (int j = 0; j < 4; ++j) { const v4u w = *(const v4u*)(hr + 512 * j + 8 * lane);
                f32x4 v0, v1; v0[0] = bf_lo(w.x); v0[1] = bf_hi(w.x); v0[2] = bf_lo(w.y); v0[3] = bf_hi(w.y); v1[0] = bf_lo(w.z); v1[1] = bf_hi(w.z); v1[2] = bf_lo(w.w); v1[3] = bf_hi(w.w);
                *(f32x4*)(yr + 512 * j + 8 * lane) = v0 * rstd * gf[2 * j]; *(f32x4*)(yr + 512 * j + 8 * lane + 4) = v1 * rstd * gf[2 * j + 1]; }
        }
    }
#undef IN
#undef BOTH
}
constexpr int NPHASE = 7;

extern "C" void kernel_launch(void* const* d_in, const int* in_sizes, int n_in, void* d_out, int out_size, void* d_ws, size_t ws_size, hipStream_t stream) {
    static int grid = 0;
    if (grid == 0) {
        if (n_in != N_IN || in_sizes[0] != MP * DM || (size_t)out_size != O_END || ws_size < WS_END) {
            fprintf(stderr, "kernel_launch: unexpected shapes (n_in %d, in0 %d, out %d, ws %zu); nothing launched\n", n_in, n_in > 0 ? in_sizes[0] : -1, out_size, ws_size); grid = -1; return; }
        int dev = 0, cus = 0, per_cu = 0;
        if (hipGetDevice(&dev) != hipSuccess || hipDeviceGetAttribute(&cus, hipDeviceAttributeMultiprocessorCount, dev) != hipSuccess) { grid = -1; return; }
        if (hipFuncSetAttribute((const void*)fox_s5_fwd, hipFuncAttributeMaxDynamicSharedMemorySize, LDS_BYTES) != hipSuccess) { fprintf(stderr, "kernel_launch: hipFuncSetAttribute failed\n"); grid = -1; return; }
        if (hipOccupancyMaxActiveBlocksPerMultiprocessor(&per_cu, (const void*)fox_s5_fwd, NTHR, LDS_BYTES) != hipSuccess || per_cu < 1)
            fprintf(stderr, "kernel_launch: note: occupancy query reports %d workgroups per CU\n", per_cu);
        (void)hipGetLastError();
        grid = cus;
    }
    if (grid < 0) return;
    (void)hipMemsetAsync((char*)d_ws + WS_CTL, 0, CTL_ZERO_BYTES, stream);
    Args a{};
    for (int i = 0; i < N_IN; ++i) a.in[i] = (const float*)d_in[i];
    a.out = (float*)d_out; a.ws = (unsigned char*)d_ws;
#if MK_ONE_LAUNCH
    a.ph_lo = 0; a.ph_hi = NPHASE;
    hipLaunchKernelGGL(fox_s5_fwd, dim3(grid), dim3(NTHR), LDS_BYTES, stream, a);
#else
    for (int ph = 0; ph < NPHASE; ++ph) { a.ph_lo = ph; a.ph_hi = ph + 1; hipLaunchKernelGGL(fox_s5_fwd, dim3(grid), dim3(NTHR), LDS_BYTES, stream, a);
#ifdef PROBE_REP
        if (ph == PROBE_REP) { const int r0 = PROBE_REP >= 5 ? 4 : PROBE_REP;
            for (int p2 = r0; p2 <= PROBE_REP; ++p2) { a.ph_lo = p2; a.ph_hi = p2 + 1; hipLaunchKernelGGL(fox_s5_fwd, dim3(grid), dim3(NTHR), LDS_BYTES, stream, a); } }
#endif
    }
#endif
}
```
